# Optimizing an MI355X kernel written in HIP

```python
import math
import jax, jax.numpy as jnp
from jax import lax
import numpy as np

D_MODEL = 1024
BATCH = 32
SEQ = 2048
DEPTH = 1

MLA_HEADS = 8
MLA_Q_RANK = 256
MLA_KV_RANK = 256
MLA_NOPE = 64
MLA_ROPE = 32
MLA_V = 64
ROPE_BASE = 10000.0
DSA_HEADS = 8
DSA_HEAD_DIM = 64
IDX_HEADS = 8
IDX_DIM = 32
TOPK_MAX = 256
D_FF = int(math.ceil(8 * D_MODEL / 3 / 256)) * 256
ALPHA = (2 * DEPTH) ** 0.25
BETA = (8 * DEPTH) ** -0.25
LN_EPS = 1e-5
RMS_EPS = 1e-6
QBLOCK = 128

MLA_WIDTH = MLA_HEADS * MLA_V
DSA_WIDTH = DSA_HEADS * DSA_HEAD_DIM
SPLIT_SIZES = (
    MLA_Q_RANK,
    MLA_KV_RANK,
    MLA_ROPE,
    DSA_WIDTH,
    DSA_WIDTH,
    DSA_WIDTH,
    IDX_HEADS * IDX_DIM,
    IDX_DIM,
    IDX_HEADS,
    D_MODEL,
    D_MODEL,
)
D_IN = sum(SPLIT_SIZES)

kernel_name = "hybrid_mla_dsa_gated_deepnorm"


def split_cols(t):
    out = []
    start = 0
    for n in SPLIT_SIZES:
        out.append(t[..., start:start + n])
        start += n
    return out


def layer_norm(x, g, b):
    xf = x.astype(jnp.float32)
    mu = jnp.mean(xf, axis=-1, keepdims=True)
    var = jnp.mean(jnp.square(xf - mu), axis=-1, keepdims=True)
    y = (xf - mu) * lax.rsqrt(var + LN_EPS) * g.astype(jnp.float32) + b.astype(jnp.float32)
    return y.astype(x.dtype)


def rms_norm(x, g):
    xf = x.astype(jnp.float32)
    y = xf * lax.rsqrt(jnp.mean(jnp.square(xf), axis=-1, keepdims=True) + RMS_EPS)
    return (y * g.astype(jnp.float32)).astype(x.dtype)


def rope(x, pos):
    half = x.shape[-1] // 2
    inv_freq = ROPE_BASE ** (-jnp.arange(half, dtype=jnp.float32) / half)
    ang = pos.astype(jnp.float32)[:, :, None, None] * inv_freq
    cos, sin = jnp.cos(ang), jnp.sin(ang)
    xf = x.astype(jnp.float32)
    x1, x2 = xf[..., :half], xf[..., half:]
    return jnp.concatenate([x1 * cos - x2 * sin, x2 * cos + x1 * sin], axis=-1).astype(x.dtype)


def alibi_slopes(n):
    return jnp.asarray([2.0 ** (-8.0 * (i + 1) / n) for i in range(n)], dtype=jnp.float32)


def to_blocks(t):
    b, s = t.shape[0], t.shape[1]
    return jnp.moveaxis(t.reshape((b, s // QBLOCK, QBLOCK) + t.shape[2:]), 1, 0)


def from_blocks(t):
    t = jnp.moveaxis(t, 0, 1)
    return t.reshape((t.shape[0], t.shape[1] * t.shape[2]) + t.shape[3:])


def mla_attention(q_nope, q_rope, k_nope, k_rope, v, pos):
    scale = 1.0 / math.sqrt(MLA_NOPE + MLA_ROPE)

    def block(args):
        qn, qr, qp = args
        s = jnp.einsum('bqhd,bshd->bhqs', qn, k_nope) + jnp.einsum('bqhd,bsd->bhqs', qr, k_rope)
        s = s.astype(jnp.float32) * scale
        causal = pos[:, None, None, :] <= qp[:, None, :, None]
        s = jnp.where(causal, s, -jnp.inf)
        p = jax.nn.softmax(s, axis=-1).astype(v.dtype)
        return jnp.einsum('bhqs,bshd->bqhd', p, v)

    out = lax.map(block, (to_blocks(q_nope), to_blocks(q_rope), to_blocks(pos)))
    return from_blocks(out)


def dsa_attention(q, k, v, q_idx, k_idx, w_idx, pos):
    n_keys = k.shape[1]
    topk = min(TOPK_MAX, n_keys // 4)
    scale = 1.0 / math.sqrt(DSA_HEAD_DIM)
    idx_scale = 1.0 / math.sqrt(IDX_DIM * IDX_HEADS)
    slopes = alibi_slopes(DSA_HEADS)
    gather = jax.vmap(lambda table, ind: table[ind])

    def block(args):
        qb, qib, wb, qp = args
        dots = jnp.einsum('bqhd,bsd->bhqs', qib, k_idx).astype(jnp.float32)
        score = jnp.einsum('bqh,bhqs->bqs', wb.astype(jnp.float32), jax.nn.relu(dots)) * idx_scale
        causal = pos[:, None, :] <= qp[:, :, None]
        score = jnp.where(causal, score, -jnp.inf)
        _, sel = lax.top_k(score, topk)
        k_sel = gather(k, sel)
        v_sel = gather(v, sel)
        p_sel = gather(pos, sel)
        valid = p_sel <= qp[:, :, None]
        s = jnp.einsum('bqhd,bqkhd->bhqk', qb, k_sel).astype(jnp.float32) * scale
        dist = (qp[:, :, None] - p_sel).astype(jnp.float32)
        s = s - slopes[None, :, None, None] * dist[:, None]
        s = jnp.where(valid[:, None], s, -jnp.inf)
        p = jax.nn.softmax(s, axis=-1).astype(v.dtype)
        return jnp.einsum('bhqk,bqkhd->bqhd', p, v_sel)

    out = lax.map(block, (to_blocks(q), to_blocks(q_idx), to_blocks(w_idx), to_blocks(pos)))
    return from_blocks(out)


def setup_inputs(seed: int = 0) -> dict:
    key = jax.random.key(seed)
    ks = jax.random.split(key, 20)
    f32 = jnp.float32

    def nrm(k, shape, scale):
        return jax.random.normal(k, shape, f32) * scale

    L = DEPTH
    x = jax.random.normal(ks[0], (BATCH, SEQ, D_MODEL), f32)
    positions = jnp.broadcast_to(jnp.arange(SEQ, dtype=jnp.int32), (BATCH, SEQ))
    return {
        "x": x,
        "positions": positions,
        "w_in": nrm(ks[1], (L, D_MODEL, D_IN), D_MODEL ** -0.5),
        "mla_q_norm": 1.0 + nrm(ks[2], (L, MLA_Q_RANK), 0.01),
        "mla_kv_norm": 1.0 + nrm(ks[3], (L, MLA_KV_RANK), 0.01),
        "mla_w_uq": nrm(ks[4], (L, MLA_Q_RANK, MLA_HEADS * (MLA_NOPE + MLA_ROPE)), MLA_Q_RANK ** -0.5),
        "mla_w_ukv": nrm(ks[5], (L, MLA_KV_RANK, MLA_HEADS * (MLA_NOPE + MLA_V)), MLA_KV_RANK ** -0.5),
        "w_branch_a": nrm(ks[6], (L, MLA_WIDTH, D_MODEL), BETA * MLA_WIDTH ** -0.5),
        "w_branch_b": nrm(ks[7], (L, DSA_WIDTH, D_MODEL), BETA * DSA_WIDTH ** -0.5),
        "w_out": nrm(ks[8], (L, D_MODEL, D_MODEL), BETA * D_MODEL ** -0.5),
        "ln1_g": 1.0 + nrm(ks[9], (L, D_MODEL), 0.01),
        "ln1_b": nrm(ks[10], (L, D_MODEL), 0.01),
        "ffn_w_in": nrm(ks[11], (L, D_MODEL, 2 * D_FF), D_MODEL ** -0.5),
        "ffn_w_down": nrm(ks[12], (L, D_FF, D_MODEL), BETA * D_FF ** -0.5),
        "ln2_g": 1.0 + nrm(ks[13], (L, D_MODEL), 0.01),
        "ln2_b": nrm(ks[14], (L, D_MODEL), 0.01),
    }


def reference(x, positions, w_in, mla_q_norm, mla_kv_norm, mla_w_uq, mla_w_ukv,
              w_branch_a, w_branch_b, w_out, ln1_g, ln1_b, ffn_w_in, ffn_w_down,
              ln2_g, ln2_b):
    B, S, _ = x.shape
    h = x
    for l in range(DEPTH):
        proj = jnp.einsum('bsd,de->bse', h, w_in[l])
        c_q, c_kv, k_r, q_b, k_b, v_b, q_i, k_i, w_i, g_a, g_b = split_cols(proj)

        c_q = rms_norm(c_q, mla_q_norm[l])
        q_a = jnp.einsum('bsr,re->bse', c_q, mla_w_uq[l]).reshape(B, S, MLA_HEADS, MLA_NOPE + MLA_ROPE)
        q_nope = q_a[..., :MLA_NOPE]
        q_rope = rope(q_a[..., MLA_NOPE:], positions)
        c_kv = rms_norm(c_kv, mla_kv_norm[l])
        kv = jnp.einsum('bsr,re->bse', c_kv, mla_w_ukv[l]).reshape(B, S, MLA_HEADS, MLA_NOPE + MLA_V)
        k_nope, v_a = kv[..., :MLA_NOPE], kv[..., MLA_NOPE:]
        k_rope = rope(k_r[:, :, None, :], positions)[:, :, 0]
        o_a = mla_attention(q_nope, q_rope, k_nope, k_rope, v_a, positions).reshape(B, S, MLA_WIDTH)

        o_b = dsa_attention(
            q_b.reshape(B, S, DSA_HEADS, DSA_HEAD_DIM),
            k_b.reshape(B, S, DSA_HEADS, DSA_HEAD_DIM),
            v_b.reshape(B, S, DSA_HEADS, DSA_HEAD_DIM),
            q_i.reshape(B, S, IDX_HEADS, IDX_DIM), k_i, w_i, positions,
        ).reshape(B, S, DSA_WIDTH)

        y_a = jnp.einsum('bse,ed->bsd', o_a, w_branch_a[l])
        y_b = jnp.einsum('bse,ed->bsd', o_b, w_branch_b[l])
        mixed = jax.nn.sigmoid(g_a) * y_a + jax.nn.sigmoid(g_b) * y_b
        mix_out = jnp.einsum('bsd,de->bse', mixed, w_out[l])
        h = layer_norm(ALPHA * h + mix_out, ln1_g[l], ln1_b[l])

        gu = jnp.einsum('bsd,df->bsf', h, ffn_w_in[l])
        gate, up = gu[..., :D_FF], gu[..., D_FF:]
        f = jnp.einsum('bsf,fd->bsd', jax.nn.silu(gate) * up, ffn_w_down[l])
        h = layer_norm(ALPHA * h + f, ln2_g[l], ln2_b[l])
    return h
```

```cpp
#include <hip/hip_runtime.h>
#include <hip/hip_bf16.h>
#include <cstdio>
#include <cstdint>
#include <cmath>

constexpr int BATCH = 32, SEQ = 2048, DM = 1024, M = BATCH * SEQ;
constexpr int D_IN = 4424, N_IN = 4608;
constexpr int DFF = 2816;
constexpr float ALPHA = 1.189207115002721f;
constexpr float LN_EPS = 1e-5f, RMS_EPS = 1e-6f;
constexpr float LOG2E = 1.4426950408889634f;
constexpr float QSCALE_MLA = 0.10206207261596575f * LOG2E;
constexpr float QSCALE_DSA = 0.125f * LOG2E;
constexpr float IDX_SCALE = 0.0625f;

namespace pg8 {
#define PG8_LAS __attribute__((address_space(3)))
typedef unsigned short bf16_t;
typedef short bf16x8 __attribute__((ext_vector_type(8)));
typedef float f32x4 __attribute__((ext_vector_type(4)));
typedef unsigned u32x4 __attribute__((ext_vector_type(4)));
constexpr int BM = 256, BK = 64, HALF = 128, HTB = HALF * BK * 2  , STAGE_BYTES = 8 * HTB, NXCD = 8, WGM = 8;

__host__ __device__ __forceinline__ int lds_byte(int r, int c) { const int st = (r >> 4) * 2 + (c >> 5), rr = r & 15, cc = c & 31, ob = rr * 64 + cc * 2; return st * 1024 + (ob ^ (((ob >> 9) & 1) << 5)); }
__host__ __device__ __forceinline__ void stage_rc(int b, int& R, int& C) { const int st = b / 1024, sb = b % 1024, swz = sb ^ (((sb >> 9) & 1) << 5); R = (st >> 1) * 16 + swz / 64; C = (st & 1) * 32 + (swz % 64) / 2; }
__host__ __device__ __forceinline__ int perm32(int rho) { const int n = rho >> 4, i = rho & 15; return 8 * (i >> 2) + 4 * n + (i & 3); }

struct Unit { int pm, pn; };
struct Gemm { const bf16_t* A; const bf16_t* Bt; int M, N, K, lda, ldb; };

struct StaticOrder {
    int nM, nN, nwg, G, c;
    __host__ __device__ void init(int M, int N, int G_, int c_) { nM = M / BM; nN = N / BM; nwg = nM * nN; G = G_; c = c_; }
    __host__ __device__ bool next(int i, Unit& u) const {
        const long L = (long)i * G + c; if (L >= nwg) return false;
        int wgid = (int)L; { const int q = nwg / NXCD, r = nwg % NXCD, xcd = wgid % NXCD, off = wgid / NXCD; wgid = (xcd < r ? xcd * (q + 1) : r * (q + 1) + (xcd - r) * q) + off; }
        const int nig = WGM * nN, gid = wgid / nig, fm = gid * WGM, gsz = (nM - fm) < WGM ? (nM - fm) : WGM;
        u.pm = fm + ((wgid % nig) % gsz); u.pn = (wgid % nig) / gsz; return true;
    }
    __device__ __forceinline__ void a_ready(const Unit&) const {}
    __device__ __forceinline__ void done(const Unit&) const {}
};

__device__ __forceinline__ unsigned cvt_pk_bf16(float lo, float hi) { unsigned r; asm volatile("v_cvt_pk_bf16_f32 %0, %1, %2" : "=v"(r) : "v"(lo), "v"(hi)); return r; }
typedef float f32x2 __attribute__((ext_vector_type(2)));
typedef unsigned u32x2 __attribute__((ext_vector_type(2)));
__device__ __forceinline__ float bf_lo(unsigned u) { return __uint_as_float(u << 16); }
__device__ __forceinline__ float bf_hi(unsigned u) { return __uint_as_float(u & 0xffff0000u); }
__device__ __forceinline__ float sigmoidf_(float v) { return __builtin_amdgcn_rcpf(1.0f + __builtin_amdgcn_exp2f(-v * LOG2E)); }
__device__ __forceinline__ u32x4 pack8(const f32x4 v0, const f32x4 v1) { u32x4 w; w.x = cvt_pk_bf16(v0[0], v0[1]); w.y = cvt_pk_bf16(v0[2], v0[3]); w.z = cvt_pk_bf16(v1[0], v1[1]); w.w = cvt_pk_bf16(v1[2], v1[3]); return w; }
__device__ __forceinline__ void rope8(f32x4& v0, f32x4& v1, const float* cs, const float* sn, unsigned row, int fq) {
    const f32x4 c0 = *(const f32x4*)(cs + row * 16 + 8 * (fq & 1)), c1 = *(const f32x4*)(cs + row * 16 + 8 * (fq & 1) + 4);
    const f32x4 s0 = *(const f32x4*)(sn + row * 16 + 8 * (fq & 1)), s1 = *(const f32x4*)(sn + row * 16 + 8 * (fq & 1) + 4);
    const float sg = (fq < 2) ? -1.f : 1.f;
#pragma unroll
    for (int e = 0; e < 4; ++e) { const float p0 = __shfl_xor(v0[e], 32), p1 = __shfl_xor(v1[e], 32);
        v0[e] = v0[e] * c0[e] + sg * p0 * s0[e]; v1[e] = v1[e] * c1[e] + sg * p1 * s1[e]; }
}

struct EpiIn {
    static constexpr bool PERM = true, AFTER_DRAIN = false;
    bf16_t *cq, *ckv, *qb, *kb, *vb, *qi, *sga, *sgb, *kmla, *ki; float *wi, *ssq_q, *ssq_kv; const float *cs, *sn;
    __device__ __forceinline__ void operator()(const f32x4 (&acc)[2][2][4][2], const Unit& u, int wr, int wc, int fr, int fq) const {
        const int pn = u.pn; const unsigned row0 = (unsigned)(u.pm * BM + wr * 64 + fr);
#ifdef DBG_NOEPI
        return;
#endif
        if (pn < 17) {
            bf16_t* base; int ld, colt, mode = 0; float sc = 1.f; float* ssq = nullptr;
            if (pn == 0) { base = cq; ld = 256; colt = 0; ssq = ssq_q; }
            else if (pn == 1) { base = ckv; ld = 256; colt = 0; ssq = ssq_kv; }
            else if (pn < 4) { base = qb; ld = 512; colt = (pn - 2) * 256; sc = QSCALE_DSA; }
            else if (pn < 6) { base = kb; ld = 512; colt = (pn - 4) * 256; }
            else if (pn < 8) { base = vb; ld = 512; colt = (pn - 6) * 256; }
            else if (pn == 8) { base = qi; ld = 256; colt = 0; }
            else if (pn < 13) { base = sga; ld = 1024; colt = (pn - 9) * 256; mode = 1; }
            else { base = sgb; ld = 1024; colt = (pn - 13) * 256; mode = 1; }
            const int col0 = colt + wc * 32 + 8 * fq;
#pragma unroll
            for (int ai = 0; ai < 2; ++ai)
#pragma unroll
                for (int m = 0; m < 4; ++m) { const unsigned row = row0 + (unsigned)(ai * HALF + m * 16); bf16_t* rowp = base + row * ld + col0; float q = 0.f;
#pragma unroll
                    for (int bj = 0; bj < 2; ++bj) { f32x4 v0 = acc[ai][bj][m][0], v1 = acc[ai][bj][m][1];
                        q += (v0[0] * v0[0] + v0[1] * v0[1]) + (v0[2] * v0[2] + v0[3] * v0[3]) + (v1[0] * v1[0] + v1[1] * v1[1]) + (v1[2] * v1[2] + v1[3] * v1[3]);
                        if (mode == 1) {
#pragma unroll
                            for (int e = 0; e < 4; ++e) { v0[e] = sigmoidf_(v0[e]); v1[e] = sigmoidf_(v1[e]); } }
                        else { v0 = v0 * sc; v1 = v1 * sc; }
                        *(u32x4*)(rowp + bj * HALF) = pack8(v0, v1); }
                    if (ssq) { q += __shfl_xor(q, 16); q += __shfl_xor(q, 32); if (fq == 0) ssq[row * 4 + wc] = q; } }
        } else {
            if (wc == 0) {
#pragma unroll
                for (int ai = 0; ai < 2; ++ai)
#pragma unroll
                    for (int m = 0; m < 4; ++m) { const unsigned row = row0 + (unsigned)(ai * HALF + m * 16); f32x4 v0 = acc[ai][0][m][0], v1 = acc[ai][0][m][1];
                        rope8(v0, v1, cs, sn, row, fq); const u32x4 w = pack8(v0, v1); bf16_t* kp = kmla + row * 768 + 64 + 8 * fq;
#pragma unroll
                        for (int h = 0; h < 8; ++h) *(u32x4*)(kp + h * 96) = w;
                        asm volatile("" ::: "memory"); }
            } else if (wc == 1) {
#pragma unroll
                for (int ai = 0; ai < 2; ++ai)
#pragma unroll
                    for (int m = 0; m < 4; ++m) { const unsigned row = row0 + (unsigned)(ai * HALF + m * 16); *(u32x4*)(ki + row * 32 + 8 * fq) = pack8(acc[ai][0][m][0], acc[ai][0][m][1]); }
            } else if (wc == 2) {
                if (fq == 0) {
#pragma unroll
                    for (int ai = 0; ai < 2; ++ai)
#pragma unroll
                        for (int m = 0; m < 4; ++m) { const unsigned row = row0 + (unsigned)(ai * HALF + m * 16); *(f32x4*)(wi + row * 8) = acc[ai][0][m][0] * IDX_SCALE; *(f32x4*)(wi + row * 8 + 4) = acc[ai][0][m][1] * IDX_SCALE; } }
            }
        }
    }
};

struct EpiUq {
    static constexpr bool PERM = true, AFTER_DRAIN = false;
    bf16_t* qm; const float* ssq; const float *cs, *sn;
    __device__ __forceinline__ void operator()(const f32x4 (&acc)[2][2][4][2], const Unit& u, int wr, int wc, int fr, int fq) const {
        const int pn = u.pn; const unsigned row0 = (unsigned)(u.pm * BM + wr * 64 + fr);
#pragma unroll
        for (int ai = 0; ai < 2; ++ai)
#pragma unroll
            for (int m = 0; m < 4; ++m) { const unsigned row = row0 + (unsigned)(ai * HALF + m * 16); const f32x4 p = *(const f32x4*)(ssq + row * 4);
                const float sc = QSCALE_MLA * __builtin_amdgcn_rsqf(((p[0] + p[1]) + (p[2] + p[3])) * (1.0f / 256.0f) + RMS_EPS);
#pragma unroll
                for (int bj = 0; bj < 2; ++bj) { f32x4 v0 = acc[ai][bj][m][0] * sc, v1 = acc[ai][bj][m][1] * sc;
                    if (pn < 2) { const int c = pn * 256 + bj * HALF + wc * 32 + 8 * fq; *(u32x4*)(qm + row * 768 + (c >> 6) * 96 + (c & 63)) = pack8(v0, v1); }
                    else { rope8(v0, v1, cs, sn, row, fq); const int h = bj * 4 + wc; *(u32x4*)(qm + row * 768 + h * 96 + 64 + 8 * fq) = pack8(v0, v1); } }
                asm volatile("" ::: "memory"); }
    }
};
struct EpiUkv {
    static constexpr bool PERM = true, AFTER_DRAIN = false;
    bf16_t *km, *va; const float* ssq;
    __device__ __forceinline__ void operator()(const f32x4 (&acc)[2][2][4][2], const Unit& u, int wr, int wc, int fr, int fq) const {
        const int pn = u.pn; const unsigned row0 = (unsigned)(u.pm * BM + wr * 64 + fr);
#pragma unroll
        for (int ai = 0; ai < 2; ++ai)
#pragma unroll
            for (int m = 0; m < 4; ++m) { const unsigned row = row0 + (unsigned)(ai * HALF + m * 16); const f32x4 p = *(const f32x4*)(ssq + row * 4);
                const float sc = __builtin_amdgcn_rsqf(((p[0] + p[1]) + (p[2] + p[3])) * (1.0f / 256.0f) + RMS_EPS);
#pragma unroll
                for (int bj = 0; bj < 2; ++bj) { const f32x4 v0 = acc[ai][bj][m][0] * sc, v1 = acc[ai][bj][m][1] * sc; const int c = (pn & 1) * 256 + bj * HALF + wc * 32 + 8 * fq;
                    if (pn < 2) *(u32x4*)(km + row * 768 + (c >> 6) * 96 + (c & 63)) = pack8(v0, v1);
                    else *(u32x4*)(va + row * 512 + c) = pack8(v0, v1); }
                asm volatile("" ::: "memory"); }
    }
};
template <bool ADD> struct EpiGate {
    static constexpr bool PERM = true, AFTER_DRAIN = false;
    const bf16_t* gate; const bf16_t* prev; bf16_t* out;
    __device__ __forceinline__ void operator()(const f32x4 (&acc)[2][2][4][2], const Unit& u, int wr, int wc, int fr, int fq) const {
        const unsigned row0 = (unsigned)(u.pm * BM + wr * 64 + fr); const int col0 = u.pn * BM + wc * 32 + 8 * fq;
#pragma unroll
        for (int ai = 0; ai < 2; ++ai)
#pragma unroll
            for (int m = 0; m < 4; ++m) { const unsigned off = (row0 + (unsigned)(ai * HALF + m * 16)) * 1024u + (unsigned)col0;
#pragma unroll
                for (int bj = 0; bj < 2; ++bj) { const u32x4 g = *(const u32x4*)(gate + off + bj * HALF); f32x4 v0 = acc[ai][bj][m][0], v1 = acc[ai][bj][m][1];
                    v0[0] *= bf_lo(g.x); v0[1] *= bf_hi(g.x); v0[2] *= bf_lo(g.y); v0[3] *= bf_hi(g.y); v1[0] *= bf_lo(g.z); v1[1] *= bf_hi(g.z); v1[2] *= bf_lo(g.w); v1[3] *= bf_hi(g.w);
                    if (ADD) { const u32x4 p = *(const u32x4*)(prev + off + bj * HALF);
                        v0[0] += bf_lo(p.x); v0[1] += bf_hi(p.x); v0[2] += bf_lo(p.y); v0[3] += bf_hi(p.y); v1[0] += bf_lo(p.z); v1[1] += bf_hi(p.z); v1[2] += bf_lo(p.w); v1[3] += bf_hi(p.w); }
                    *(u32x4*)(out + off + bj * HALF) = pack8(v0, v1); } }
    }
};
struct EpiResF32 {
    static constexpr bool PERM = false, AFTER_DRAIN = false;
    const float* x; float* out;
    __device__ __forceinline__ void operator()(const f32x4 (&acc)[2][2][4][2], const Unit& u, int wr, int wc, int fr, int fq) const {
        const unsigned row0 = (unsigned)(u.pm * BM + wr * 64 + fr); const int col0 = u.pn * BM + wc * 32 + 4 * fq;
#pragma unroll
        for (int ai = 0; ai < 2; ++ai)
#pragma unroll
            for (int m = 0; m < 4; ++m) { const unsigned off = (row0 + (unsigned)(ai * HALF + m * 16)) * 1024u + (unsigned)col0;
#pragma unroll
                for (int bj = 0; bj < 2; ++bj)
#pragma unroll
                    for (int n = 0; n < 2; ++n) { const f32x4 xv = *(const f32x4*)(x + off + bj * HALF + n * 16); *(f32x4*)(out + off + bj * HALF + n * 16) = xv * ALPHA + acc[ai][bj][m][n]; } }
    }
};
struct EpiSwiglu {
    static constexpr bool PERM = true, AFTER_DRAIN = false;
    bf16_t* out;
    __device__ __forceinline__ void operator()(const f32x4 (&acc)[2][2][4][2], const Unit& u, int wr, int wc, int fr, int fq) const {
        const unsigned row0 = (unsigned)(u.pm * BM + wr * 64 + fr); const int col0 = u.pn * HALF + wc * 32 + 8 * fq;
#pragma unroll
        for (int ai = 0; ai < 2; ++ai)
#pragma unroll
            for (int m = 0; m < 4; ++m) { f32x4 v[2];
#pragma unroll
                for (int n = 0; n < 2; ++n)
#pragma unroll
                    for (int e = 0; e < 4; ++e) { const float g = acc[ai][0][m][n][e]; v[n][e] = g * sigmoidf_(g) * acc[ai][1][m][n][e]; }
                *(u32x4*)(out + (row0 + ai * HALF + m * 16) * DFF + col0) = pack8(v[0], v[1]); }
    }
};
struct EpiResBf {
    static constexpr bool PERM = false, AFTER_DRAIN = false;
    const bf16_t* h; float* out;
    __device__ __forceinline__ void operator()(const f32x4 (&acc)[2][2][4][2], const Unit& u, int wr, int wc, int fr, int fq) const {
        const unsigned row0 = (unsigned)(u.pm * BM + wr * 64 + fr); const int col0 = u.pn * BM + wc * 32 + 4 * fq;
#pragma unroll
        for (int ai = 0; ai < 2; ++ai)
#pragma unroll
            for (int m = 0; m < 4; ++m) { const unsigned off = (row0 + (unsigned)(ai * HALF + m * 16)) * 1024u + (unsigned)col0;
#pragma unroll
                for (int bj = 0; bj < 2; ++bj)
#pragma unroll
                    for (int n = 0; n < 2; ++n) { const u32x2 hv = *(const u32x2*)(h + off + bj * HALF + n * 16); const f32x4 a = acc[ai][bj][m][n];
                        *(f32x4*)(out + off + bj * HALF + n * 16) = (f32x4){bf_lo(hv.x) * ALPHA + a[0], bf_hi(hv.x) * ALPHA + a[1], bf_lo(hv.y) * ALPHA + a[2], bf_hi(hv.y) * ALPHA + a[3]}; } }
    }
};

template <class Epi, class Sched, bool ALIGN_EPI = false>
__device__ __forceinline__ void gemm_phase(PG8_LAS unsigned char* lds, const Gemm g, const Sched& S, const Epi& E) {
    int tid_ = threadIdx.x; asm volatile("" : "+v"(tid_));
    const int tid = tid_, wid = __builtin_amdgcn_readfirstlane(tid >> 6), lane = tid & 63, wr = wid >> 2, wc = wid & 3, fr = lane & 15, fq = lane >> 4;
    int K_ = g.K, lda_ = g.lda, ldb_ = g.ldb; asm volatile("" : "+s"(K_)); asm volatile("" : "+s"(lda_)); asm volatile("" : "+s"(ldb_));
    const int K = K_, nt = K / BK;
    unsigned voffA[2], voffB[2];
#pragma unroll
    for (int i = 0; i < 2; ++i) { int R, C; stage_rc(tid * 16 + i * 8192, R, C); const int Rb = Epi::PERM ? ((R & ~31) + perm32(R & 31)) : R;
        voffA[i] = (unsigned)(R * lda_ + C) * 2u; voffB[i] = (unsigned)(Rb * ldb_ + C) * 2u; }
    const size_t kstep = (size_t)(BK * 2);
    const size_t hstepA = (size_t)HALF * lda_ * 2, hstepB = (size_t)HALF * ldb_ * 2;
    const size_t tstepA = 2 * hstepA, tstepB = 2 * hstepB;
    const unsigned ldsw = (unsigned)wid * 1024u;
    const int aoff = lds_byte(wr * 64 + fr, fq * 8), boff = lds_byte(wc * 32 + fr, fq * 8);
#define PG8_SA(b, h) (((b) * 2 + (h)) * HTB)
#define PG8_SB(b, h) ((4 + (b) * 2 + (h)) * HTB)
#define PG8_STAGE(bufoff, gbase, voff) do { _Pragma("unroll") for (int _i = 0; _i < 2; ++_i) \
        __builtin_amdgcn_global_load_lds((const unsigned*)((const char*)(gbase) + (voff)[_i]), (PG8_LAS unsigned*)(lds + (bufoff) + ldsw + _i * 8192), 16, 0, 0); } while (0)
#define PG8_LDA(dst, b, h) do { _Pragma("unroll") for (int m = 0; m < 4; ++m) _Pragma("unroll") for (int k = 0; k < 2; ++k) dst[m][k] = *(const PG8_LAS bf16x8*)(lds + PG8_SA(b, h) + aoff + m * 2048 + k * 1024); } while (0)
#define PG8_LDB(dst, b, h) do { _Pragma("unroll") for (int n = 0; n < 2; ++n) _Pragma("unroll") for (int k = 0; k < 2; ++k) dst[n][k] = *(const PG8_LAS bf16x8*)(lds + PG8_SB(b, h) + boff + n * 2048 + k * 1024); } while (0)
#define PG8_MMA(ai, bj, At, Bt) do { __builtin_amdgcn_s_setprio(1); _Pragma("unroll") for (int m = 0; m < 4; ++m) _Pragma("unroll") for (int n = 0; n < 2; ++n) _Pragma("unroll") for (int k = 0; k < 2; ++k) \
        acc[ai][bj][m][n] = __builtin_amdgcn_mfma_f32_16x16x32_bf16(Bt[n][k], At[m][k], acc[ai][bj][m][n], 0, 0, 0); __builtin_amdgcn_s_setprio(0); } while (0)
#define PG8_WAIT_V(n) asm volatile("s_waitcnt vmcnt(" #n ")" ::: "memory")
#define PG8_WAIT_L(n) asm volatile("s_waitcnt lgkmcnt(" #n ")" ::: "memory")
#define PG8_BAR __builtin_amdgcn_s_barrier()
#define PG8_SCHED __builtin_amdgcn_sched_barrier(0)
    Unit cur, nxt; int ui = 0;
    if (!S.next(0, cur)) return;
    f32x4 acc[2][2][4][2];
#pragma unroll
    for (int a = 0; a < 2; ++a)
#pragma unroll
        for (int b = 0; b < 2; ++b)
#pragma unroll
            for (int m = 0; m < 4; ++m)
#pragma unroll
                for (int n = 0; n < 2; ++n) acc[a][b][m][n] = (f32x4){0.f, 0.f, 0.f, 0.f};
    bf16x8 At[4][2], B0[2][2], B1[2][2];
    const char* cA = (const char*)g.A + (size_t)cur.pm * tstepA; const char* cB = (const char*)g.Bt + (size_t)cur.pn * tstepB;
    S.a_ready(cur);
    {
        PG8_STAGE(PG8_SB(0, 0), cB, voffB); PG8_STAGE(PG8_SB(0, 1), cB + hstepB, voffB); PG8_STAGE(PG8_SA(0, 0), cA, voffA); PG8_STAGE(PG8_SA(0, 1), cA + hstepA, voffA);
        if (wr == 1) PG8_BAR;
        PG8_WAIT_V(2); PG8_BAR;
        PG8_STAGE(PG8_SB(1, 0), cB + kstep, voffB); PG8_STAGE(PG8_SA(1, 0), cA + kstep, voffA); PG8_STAGE(PG8_SB(1, 1), cB + hstepB + kstep, voffB);
        PG8_WAIT_V(6); PG8_BAR;
    }
    for (;;) {
        const bool has_next = S.next(ui + 1, nxt);
        const char* nA = has_next ? (const char*)g.A + (size_t)nxt.pm * tstepA : cA; const char* nB = has_next ? (const char*)g.Bt + (size_t)nxt.pn * tstepB : cB;
        for (int t = 0; t < nt; t += 2) {
            const bool last = (t == nt - 2);
            const char* a1 = cA + (size_t)(t + 1) * kstep;
            const char* a2 = last ? nA : cA + (size_t)(t + 2) * kstep; const char* b2 = last ? nB : cB + (size_t)(t + 2) * kstep;
            const char* a3 = a2 + kstep; const char* b3 = b2 + kstep;
            if (last && has_next) S.a_ready(nxt);
            {
            PG8_LDB(B0, 0, 0); PG8_LDB(B1, 0, 1); PG8_SCHED; PG8_LDA(At, 0, 0); PG8_STAGE(PG8_SA(1, 1), a1 + hstepA, voffA);
            PG8_WAIT_V(8); PG8_WAIT_L(0); PG8_BAR; PG8_MMA(0, 0, At, B0); PG8_MMA(0, 1, At, B1); PG8_BAR; PG8_SCHED;
            PG8_LDA(At, 0, 1); PG8_STAGE(PG8_SB(0, 0), b2, voffB); PG8_STAGE(PG8_SB(0, 1), b2 + hstepB, voffB); PG8_STAGE(PG8_SA(0, 0), a2, voffA);
            PG8_WAIT_V(8); PG8_WAIT_L(0); PG8_BAR; PG8_MMA(1, 0, At, B0); PG8_MMA(1, 1, At, B1); PG8_BAR; PG8_SCHED;
            PG8_LDB(B0, 1, 0); PG8_LDB(B1, 1, 1); PG8_SCHED; PG8_LDA(At, 1, 0); PG8_STAGE(PG8_SA(0, 1), a2 + hstepA, voffA);
            PG8_WAIT_V(8); PG8_WAIT_L(0); PG8_BAR; PG8_MMA(0, 0, At, B0); PG8_MMA(0, 1, At, B1); PG8_BAR; PG8_SCHED;
            PG8_LDA(At, 1, 1); PG8_STAGE(PG8_SB(1, 0), b3, voffB); PG8_STAGE(PG8_SB(1, 1), b3 + hstepB, voffB); PG8_STAGE(PG8_SA(1, 0), a3, voffA);
            PG8_WAIT_V(8); PG8_WAIT_L(0); PG8_BAR; PG8_MMA(1, 0, At, B0); PG8_MMA(1, 1, At, B1); PG8_BAR; PG8_SCHED;
            }
        }
        if constexpr (ALIGN_EPI) { if (wr == 0) PG8_BAR; }
        if constexpr (!Epi::AFTER_DRAIN) { E(acc, cur, wr, wc, fr, fq); S.done(cur); }
        if (!has_next) break;
#pragma unroll
        for (int a = 0; a < 2; ++a)
#pragma unroll
            for (int b = 0; b < 2; ++b)
#pragma unroll
                for (int m = 0; m < 4; ++m)
#pragma unroll
                    for (int n = 0; n < 2; ++n) acc[a][b][m][n] = (f32x4){0.f, 0.f, 0.f, 0.f};
        cur = nxt; cA = nA; cB = nB; ++ui;
        if constexpr (ALIGN_EPI) { if (wr == 1) PG8_BAR; }
    }
    PG8_WAIT_V(0);
    if constexpr (!ALIGN_EPI) { if (wr == 0) PG8_BAR; }
    PG8_BAR;
    if constexpr (Epi::AFTER_DRAIN) { E.fused(acc, cur, wr, wc, fr, fq, lds, wid, lane); S.done(cur); }
#undef PG8_SA
#undef PG8_SB
#undef PG8_STAGE
#undef PG8_LDA
#undef PG8_LDB
#undef PG8_MMA
#undef PG8_WAIT_V
#undef PG8_WAIT_L
#undef PG8_BAR
#undef PG8_SCHED
}
}

namespace att {
using bf16 = unsigned short;
using bf16x8 = __attribute__((ext_vector_type(8))) short;
using s16x4 = __attribute__((ext_vector_type(4))) short;
using f32x16 = __attribute__((ext_vector_type(16))) float;
using u32x4 = __attribute__((ext_vector_type(4))) unsigned;
using u32x2 = __attribute__((ext_vector_type(2))) unsigned;
constexpr int NW = 8, QBLK = 32, QB = 256, KVBLK = 64, NSLOT = 3;
constexpr int KSLOT = 12288, VSLOT = 8192;
constexpr int LDS_K = 0, LDS_V = NSLOT * KSLOT, LDS_WS = LDS_V + NSLOT * VSLOT, LDS_OST = LDS_WS + NW * 64 * 4, LDS_BYTES = LDS_OST + NW * 4096;
__device__ __forceinline__ int crow(int r, int hi) { return (r & 3) + 8 * (r >> 2) + 4 * hi; }
#define ATT_SBAR() __builtin_amdgcn_sched_barrier(0)
__device__ __forceinline__ void glds16(const void* gsrc, unsigned lds_dst) { unsigned keep;
    asm volatile("s_mov_b32 %0, m0\n\ts_mov_b32 m0, %2\n\ts_nop 0\n\tglobal_load_lds_dwordx4 %1, off\n\ts_mov_b32 m0, %0" : "=&s"(keep) : "v"(gsrc), "s"(lds_dst) : "memory"); }
__device__ __forceinline__ float max3f(float a, float b, float c) { float r; asm("v_max3_f32 %0, %1, %2, %3" : "=v"(r) : "v"(a), "v"(b), "v"(c)); return r; }
typedef float f32x2_t __attribute__((ext_vector_type(2))); typedef __bf16 bf16x2_t __attribute__((ext_vector_type(2)));
__device__ __forceinline__ unsigned cvtpk_s(float lo, float hi) { f32x2_t v = {lo, hi}; bf16x2_t b = __builtin_convertvector(v, bf16x2_t); return __builtin_bit_cast(unsigned, b); }
#define ATT_WAIT_BAR(N) asm volatile("s_waitcnt vmcnt(" #N ") lgkmcnt(0)\n\ts_barrier" ::: "memory")
typedef __attribute__((address_space(3))) char LDSC;
#define ATT_LAS __attribute__((address_space(3)))

__device__ __forceinline__ float rowmax(const f32x16& p0, const f32x16& p1) {
    float a = max3f(p0[0], p0[1], p1[0]), b = max3f(p0[2], p0[3], p1[1]); a = max3f(a, p1[2], p1[3]);
#pragma unroll
    for (int r = 4; r < 16; r += 4) { a = max3f(a, p0[r], p0[r + 1]); b = max3f(b, p0[r + 2], p0[r + 3]); a = max3f(a, p1[r], p1[r + 1]); b = max3f(b, p1[r + 2], p1[r + 3]); }
    const float m = fmaxf(a, b);
    auto rr = __builtin_amdgcn_permlane32_swap(__float_as_uint(m), __float_as_uint(m), false, false);
    return fmaxf(__uint_as_float(rr[0]), __uint_as_float(rr[1]));
}
__device__ __forceinline__ void pv(f32x16* o, int vb, bf16x8 pa0, bf16x8 pa1, bf16x8 pa2, bf16x8 pa3) {
#pragma unroll
    for (int d0 = 0; d0 < 2; ++d0) { s16x4 lo[4], hi[4];
#pragma unroll
        for (int ks = 0; ks < 4; ++ks) {
            asm volatile("ds_read_b64_tr_b16 %0,%1 offset:%c2" : "=&v"(lo[ks]) : "v"(vb), "i"(d0 * 4096 + ks * 1024) : "memory");
            asm volatile("ds_read_b64_tr_b16 %0,%1 offset:%c2" : "=&v"(hi[ks]) : "v"(vb), "i"(d0 * 4096 + ks * 1024 + 512) : "memory"); }
        asm volatile("s_waitcnt lgkmcnt(0)" : "+v"(lo[0]), "+v"(lo[1]), "+v"(lo[2]), "+v"(lo[3]), "+v"(hi[0]), "+v"(hi[1]), "+v"(hi[2]), "+v"(hi[3]) :: "memory"); ATT_SBAR();
#define ATT_PK(k) (bf16x8){lo[k][0], lo[k][1], lo[k][2], lo[k][3], hi[k][0], hi[k][1], hi[k][2], hi[k][3]}
        o[d0] = __builtin_amdgcn_mfma_f32_32x32x16_bf16(pa0, ATT_PK(0), o[d0], 0, 0, 0);
        o[d0] = __builtin_amdgcn_mfma_f32_32x32x16_bf16(pa1, ATT_PK(1), o[d0], 0, 0, 0);
        o[d0] = __builtin_amdgcn_mfma_f32_32x32x16_bf16(pa2, ATT_PK(2), o[d0], 0, 0, 0);
        o[d0] = __builtin_amdgcn_mfma_f32_32x32x16_bf16(pa3, ATT_PK(3), o[d0], 0, 0, 0);
#undef ATT_PK
    }
}

struct AttnArgs {
    const bf16* Q; int qpitch;
    const bf16* K; int kpitch;
    const bf16* V; int vpitch;
    bf16* O; int opitch; int ocol;
    const unsigned* mask;
};

template <int NDK, bool DSA> __device__ __forceinline__ void attn_unit(int b, int h, int qb, const AttnArgs& T, float slope2, LDSC* shm) {
    constexpr int DQK = NDK * 16, NKP = 2 * NDK;
    int tid_ = threadIdx.x; asm volatile("" : "+v"(tid_));
    const int tid = tid_, lane = tid & 63, r32 = lane & 31, hi = lane >> 5; const int wid = __builtin_amdgcn_readfirstlane(tid >> 6);
    const long rowbase = (long)b * SEQ; const int q0 = qb * QB;
    const bf16* Qw = T.Q + (rowbase + q0 + wid * QBLK) * T.qpitch + h * DQK;
    const bf16* Kh = T.K + rowbase * T.kpitch + h * DQK; const bf16* Vh = T.V + rowbase * T.vpitch + h * 64;
    const unsigned lds0 = (unsigned)(uintptr_t)shm;
    ATT_LAS float* wsf = (ATT_LAS float*)(shm + LDS_WS) + wid * 64;
    const bf16* ksrc0 = Kh + (long)lane * T.kpitch + wid * 8;
    const bf16* ksrc1 = Kh + (long)lane * T.kpitch + (8 + wid) * 8;
    const bf16* vsrc = Vh + (long)(16 * (wid & 3) + (lane >> 2)) * T.vpitch + (wid >> 2) * 32 + (lane & 3) * 8;
    const bool k2 = (NKP > 8) && (wid < NKP - 8);
    const long kstep = (long)KVBLK * T.kpitch, vstep = (long)KVBLK * T.vpitch;
    const int NT = (q0 + QB) / KVBLK;
    const long qrow = rowbase + q0 + wid * QBLK + r32;
    const unsigned* mrow = DSA ? (T.mask + qrow * 64) : nullptr;
#define ATT_DMA(t, slot) do { const int s_ = (slot); glds16(ksrc0 + (long)(t) * kstep, (unsigned)__builtin_amdgcn_readfirstlane(lds0 + LDS_K + s_ * KSLOT + wid * 1024)); \
        if (k2) glds16(ksrc1 + (long)(t) * kstep, (unsigned)__builtin_amdgcn_readfirstlane(lds0 + LDS_K + s_ * KSLOT + (8 + wid) * 1024)); \
        glds16(vsrc + (long)(t) * vstep, (unsigned)__builtin_amdgcn_readfirstlane(lds0 + LDS_V + s_ * VSLOT + wid * 1024)); } while (0)
#define ATT_TOPWAIT(younger) do { if (younger) { if (k2) ATT_WAIT_BAR(3); else ATT_WAIT_BAR(2); } else ATT_WAIT_BAR(0); } while (0)
    u32x2 mnext = {0u, 0u};
    if (DSA) mnext = *(const u32x2*)mrow;
    ATT_DMA(0, 0); ATT_DMA(1, 1);
    bf16x8 qr[NDK];
#pragma unroll
    for (int d0 = 0; d0 < NDK; ++d0) qr[d0] = *reinterpret_cast<const bf16x8*>(&Qw[(long)r32 * T.qpitch + d0 * 16 + hi * 8]);
    float m_run = -INFINITY, l_run = 0.f; f32x16 o[2]; o[0] = f32x16{}; o[1] = f32x16{};
    const int qrel = wid * QBLK + r32;
    f32x16 cb0 = f32x16{}, cb1 = f32x16{};
    if (DSA) {
#pragma unroll
        for (int r = 0; r < 16; ++r) { cb0[r] = -slope2 * (float)(q0 + qrel - crow(r, hi)); cb1[r] = cb0[r] + 32.f * slope2; }
    }
    const int vb0 = (int)(lds0 + LDS_V) + ((lane >> 4) & 1) * 32 + (lane & 3) * 8 + (4 * hi + ((lane & 15) >> 2)) * 64;
    int slot = 0;
    for (int t = 0; t < NT; ++t) {
        ATT_TOPWAIT(t + 1 < NT);
        u32x2 mcur = {0u, 0u};
        if (DSA) { mcur = mnext; asm volatile("" : "+v"(mcur)); }
        if (t + 2 < NT) { const int s2 = (slot == 0) ? 2 : slot - 1; ATT_DMA(t + 2, s2); }
        if (DSA) { if (t + 1 < NT) mnext = *(const u32x2*)(mrow + 2 * (t + 1)); }
        const int jb = t - (NT - 4);
        const bool active = (jb < 0) || (64 * jb <= wid * QBLK + 31);
        if (active) {
            f32x16 p0 = cb0, p1 = cb1;
            const LDSC* kb = shm + LDS_K + slot * KSLOT + hi * 1024 + r32 * 16;
#pragma unroll
            for (int d0 = 0; d0 < NDK; ++d0) {
                const bf16x8 b0 = *(const ATT_LAS bf16x8*)(kb + d0 * 2048);
                const bf16x8 b1 = *(const ATT_LAS bf16x8*)(kb + d0 * 2048 + 512);
                p0 = __builtin_amdgcn_mfma_f32_32x32x16_bf16(b0, qr[d0], p0, 0, 0, 0);
                p1 = __builtin_amdgcn_mfma_f32_32x32x16_bf16(b1, qr[d0], p1, 0, 0, 0); }
            asm volatile("s_nop 15\n\ts_nop 7" : "+v"(p0), "+v"(p1));
            if (DSA) {
                const unsigned w0 = mcur.x >> (4 * hi), w1 = mcur.y >> (4 * hi);
#pragma unroll
                for (int r = 0; r < 16; ++r) { const int bit = (r & 3) + 8 * (r >> 2);
                    if (!((w0 >> bit) & 1u)) p0[r] = -INFINITY; if (!((w1 >> bit) & 1u)) p1[r] = -INFINITY; }
            } else if (jb >= 0) {
                const int kb0 = 64 * jb + 4 * hi;
#pragma unroll
                for (int r = 0; r < 16; ++r) { const int kv = kb0 + (r & 3) + 8 * (r >> 2); if (kv > qrel) p0[r] = -INFINITY; if (kv + 32 > qrel) p1[r] = -INFINITY; }
            }
            const float rm = rowmax(p0, p1);
            const float mn = fmaxf(m_run, rm);
            const float mu = (mn == -INFINITY) ? 0.f : mn;
            const float f = __builtin_amdgcn_exp2f(m_run - mu);
            float rs = 0.f;
#pragma unroll
            for (int r = 0; r < 16; ++r) { p0[r] = __builtin_amdgcn_exp2f(p0[r] - mu); p1[r] = __builtin_amdgcn_exp2f(p1[r] - mu); rs += p0[r] + p1[r]; }
            l_run = l_run * f + rs;
            if (__any(mn > m_run)) {
                if (hi == 0) wsf[r32] = f;
                asm volatile("s_waitcnt lgkmcnt(0)" ::: "memory");
#pragma unroll
                for (int r = 0; r < 16; ++r) { const float fr_ = wsf[crow(r, hi)]; o[0][r] *= fr_; o[1][r] *= fr_; }
            }
            m_run = mn;
            u32x4 pw0, pw1, pw2, pw3;
            pw0 = (u32x4){cvtpk_s(p0[0], p0[1]), cvtpk_s(p0[2], p0[3]), cvtpk_s(p0[4], p0[5]), cvtpk_s(p0[6], p0[7])};
            pw1 = (u32x4){cvtpk_s(p0[8], p0[9]), cvtpk_s(p0[10], p0[11]), cvtpk_s(p0[12], p0[13]), cvtpk_s(p0[14], p0[15])};
            pw2 = (u32x4){cvtpk_s(p1[0], p1[1]), cvtpk_s(p1[2], p1[3]), cvtpk_s(p1[4], p1[5]), cvtpk_s(p1[6], p1[7])};
            pw3 = (u32x4){cvtpk_s(p1[8], p1[9]), cvtpk_s(p1[10], p1[11]), cvtpk_s(p1[12], p1[13]), cvtpk_s(p1[14], p1[15])};
            ATT_SBAR();
            pv(o, vb0 + slot * VSLOT, __builtin_bit_cast(bf16x8, pw0), __builtin_bit_cast(bf16x8, pw1), __builtin_bit_cast(bf16x8, pw2), __builtin_bit_cast(bf16x8, pw3));
        }
        if (DSA) {
#pragma unroll
            for (int r = 0; r < 16; ++r) { cb0[r] += 64.f * slope2; cb1[r] += 64.f * slope2; }
        }
        slot = (slot == NSLOT - 1) ? 0 : slot + 1;
    }
    { auto rr = __builtin_amdgcn_permlane32_swap(__float_as_uint(l_run), __float_as_uint(l_run), false, false); l_run = __uint_as_float(rr[0]) + __uint_as_float(rr[1]); }
    if (hi == 0) wsf[32 + r32] = l_run;
    asm volatile("s_waitcnt lgkmcnt(0)" ::: "memory");
    float rli[16];
#pragma unroll
    for (int r = 0; r < 16; ++r) rli[r] = __builtin_amdgcn_rcpf(wsf[32 + crow(r, hi)]);
    bf16* Ow = T.O + (rowbase + q0 + wid * QBLK) * T.opitch + T.ocol + h * 64;
    { ATT_LAS bf16* stg = (ATT_LAS bf16*)(shm + LDS_OST) + wid * 2048;
#pragma unroll
        for (int r = 0; r < 16; ++r) { const int orow = crow(r, hi);
#pragma unroll
            for (int d0 = 0; d0 < 2; ++d0) stg[orow * 64 + d0 * 32 + r32] = (bf16)(cvtpk_s(o[d0][r] * rli[r], 0.f) & 0xffffu); }
        asm volatile("s_waitcnt lgkmcnt(0)" ::: "memory");
#pragma unroll
        for (int i = 0; i < 4; ++i) { const int row = i * 8 + (lane >> 3), ch = lane & 7; const u32x4 v = *(const ATT_LAS u32x4*)(stg + row * 64 + ch * 8); *(u32x4*)(Ow + (long)row * T.opitch + ch * 8) = v; } }
    asm volatile("s_waitcnt vmcnt(0) lgkmcnt(0)\n\ts_barrier" ::: "memory");
#undef ATT_DMA
#undef ATT_TOPWAIT
}
#undef ATT_LAS
#undef ATT_SBAR
#undef ATT_WAIT_BAR
}


#define PH_MASK_DBG_ZERO_O 0
constexpr int NWAVES = 8;
#ifndef MK_N_LAUNCHES
#define MK_N_LAUNCHES 1
#endif
constexpr int PER_PHASE = 12;
constexpr int N_LAUNCHES = MK_N_LAUNCHES;
static_assert(N_LAUNCHES == 1 || N_LAUNCHES == PER_PHASE, "MK_N_LAUNCHES is 1 or 12");

constexpr size_t MiB = 1u << 20;
constexpr size_t WS_CTL = 0, CTL_ZERO_BYTES = 64 * 1024;
constexpr size_t WS_W_IN = 1 * MiB, WS_W_UQ = 10 * MiB, WS_W_UKV = 10 * MiB + 512 * 1024, WS_W_A = 11 * MiB, WS_W_B = 12 * MiB, WS_W_OUT = 13 * MiB, WS_W_FFI = 15 * MiB, WS_W_DN = 26 * MiB;
constexpr size_t WS_COS = 32 * MiB, WS_SIN = 36 * MiB, WS_SSQ_Q = 40 * MiB, WS_SSQ_KV = 41 * MiB, WS_WI = 42 * MiB, WS_KI = 44 * MiB;
constexpr size_t WS_XB = 64 * MiB;
constexpr size_t WS_VA = 64 * MiB;
constexpr size_t WS_OA = 128 * MiB;
constexpr size_t WS_MIXED = 64 * MiB;
constexpr size_t WS_H1 = 64 * MiB;
constexpr size_t WS_CQ = 192 * MiB, WS_CKV = 224 * MiB;
constexpr size_t WS_MASK = 192 * MiB;
constexpr size_t WS_QB = 256 * MiB, WS_KB = 320 * MiB, WS_VB = 384 * MiB;
constexpr size_t WS_TA = 256 * MiB;
constexpr size_t WS_QI = 448 * MiB;
constexpr size_t WS_SGA = 480 * MiB, WS_SGB = 608 * MiB;
constexpr size_t WS_KMLA = 736 * MiB;
constexpr size_t WS_OB = 736 * MiB;
constexpr size_t WS_QMLA = 832 * MiB;
constexpr size_t WS_ACT = 480 * MiB;
constexpr size_t WS_END = 928 * MiB;
static_assert(WS_ACT + (size_t)M * DFF * 2 <= WS_END && WS_W_DN + (size_t)DM * DFF * 2 <= WS_COS && WS_W_IN + (size_t)N_IN * DM * 2 <= WS_W_UQ && WS_W_FFI + (size_t)2 * DFF * DM * 2 <= WS_W_DN, "d_ws map");
constexpr int CW_TMO = 0;
constexpr int CW_BAR = 4096;

constexpr int RING_OFF = 0, RING_BYTES = 147456;
constexpr int LDSCTL_OFF = RING_BYTES, MISC_OFF = LDSCTL_OFF + 320;
constexpr int LDS_BYTES = RING_BYTES + 1024;
static_assert(att::LDS_BYTES <= RING_BYTES && pg8::STAGE_BYTES <= RING_BYTES && LDS_BYTES <= 163840, "LDS map");

typedef unsigned u32x2v __attribute__((ext_vector_type(2)));
#define GAS __attribute__((address_space(1)))
#define LAS __attribute__((address_space(3)))
typedef unsigned short bf16;
typedef unsigned v4u __attribute__((ext_vector_type(4)));
typedef float f32x4 __attribute__((ext_vector_type(4)));
typedef short bf16x8 __attribute__((ext_vector_type(8)));
typedef GAS unsigned gu32;
typedef GAS unsigned long long gu64;
#define RLX_AGENT __ATOMIC_RELAXED, __HIP_MEMORY_SCOPE_AGENT
#define LDS_WAIT() asm volatile("s_waitcnt lgkmcnt(0)" ::: "memory")
#define VM_WAIT() asm volatile("s_waitcnt vmcnt(0)" ::: "memory")
__device__ __forceinline__ unsigned long long rt() { return __builtin_amdgcn_s_memrealtime(); }
__device__ __forceinline__ unsigned f2bf(float f) { unsigned u = __builtin_bit_cast(unsigned, f); return (u + 0x7fffu + ((u >> 16) & 1u)) >> 16; }
__device__ __forceinline__ unsigned pk2(float lo, float hi) { return f2bf(lo) | (f2bf(hi) << 16); }

#define XB_TMO      128
#define XB_XCNT(j)  (256  + 64 * (j))
#define XB_XSUB(j)  (1280 + 64 * (j))
#define XB_XGEN(j)  (2304 + 64 * (j))
#define XB_TOP      3328
#define XB_TOPGEN   3392
#define XCD_BAR_WORDS 3456
#define XB_SPIN_CAP (1u << 18)

__device__ __forceinline__ unsigned xb_ld(unsigned* p)              { return __hip_atomic_load(p, __ATOMIC_RELAXED, __HIP_MEMORY_SCOPE_AGENT); }
__device__ __forceinline__ unsigned xb_add(unsigned* p, unsigned v) { return __hip_atomic_fetch_add(p, v, __ATOMIC_RELAXED, __HIP_MEMORY_SCOPE_AGENT); }
__device__ __forceinline__ unsigned xb_xcc_id() { return (unsigned)__builtin_amdgcn_s_getreg((3 << 11) | 20) & 0xFu; }
#define XB_SPIN(cond, bar) do { unsigned _sp = 0; while (cond) { __builtin_amdgcn_s_sleep(1); \
    if ((++_sp & 255u) == 0u) { if (xb_ld(&(bar)[XB_TMO])) break; if (_sp > XB_SPIN_CAP) { atomicAdd(&(bar)[XB_TMO], 1u); break; } } } } while (0)

struct XcdBarrier {
    unsigned* bar; unsigned x;
    volatile LAS unsigned* st;
};

__device__ __forceinline__ XcdBarrier xcd_barrier_post(unsigned* bar, volatile LAS unsigned* st) {
    XcdBarrier b; b.bar = bar; b.x = xb_xcc_id(); b.st = st;
    if (threadIdx.x == 0) (void)xb_add(&bar[XB_XCNT(b.x)], 1u);
    return b;
}
__device__ __forceinline__ void xcd_barrier_complete(unsigned* bar, unsigned x, unsigned& nloc, unsigned& nx) {
    const unsigned G = gridDim.x * gridDim.y * gridDim.z;
    unsigned sum, cnt, mine, sp = 0u;
    for (;;) {
        sum = 0u; cnt = 0u; mine = 0u;
#pragma unroll
        for (unsigned j = 0; j < 16; ++j) { const unsigned c = xb_ld(&bar[XB_XCNT(j)]); sum += c; cnt += (c > 0u) ? 1u : 0u; mine = (j == x) ? c : mine; }
        if (sum == G) break;
        __builtin_amdgcn_s_sleep(1);
        if ((++sp & 255u) == 0u) { if (xb_ld(&bar[XB_TMO])) break; if (sp > XB_SPIN_CAP) { atomicAdd(&bar[XB_TMO], 1u); break; } }
    }
    nloc = mine > 0u ? mine : 1u; nx = cnt > 0u ? cnt : 1u;
}

__device__ __forceinline__ void xcd_barrier(const XcdBarrier& b) {
    asm volatile("s_waitcnt vmcnt(0)" ::: "memory");
    __syncthreads();
    if (threadIdx.x == 0) {
        unsigned* bar = b.bar;
        __builtin_amdgcn_s_waitcnt(0);
        unsigned nloc = b.st[0], nx = b.st[1];
        if (nloc == 0u) { xcd_barrier_complete(bar, b.x, nloc, nx); b.st[0] = nloc; b.st[1] = nx; }
        const unsigned old = xb_add(&bar[XB_XSUB(b.x)], 1u);
        const unsigned gen = old / nloc;
        if (old + 1u == (gen + 1u) * nloc) {
            __builtin_amdgcn_fence(__ATOMIC_RELEASE, "agent");
            asm volatile("s_waitcnt vmcnt(0)" ::: "memory");
            const unsigned og = xb_add(&bar[XB_TOP], 1u);
            const unsigned tg = og / nx;
            if (og + 1u == (tg + 1u) * nx) xb_add(&bar[XB_TOPGEN], 1u);
            else XB_SPIN(xb_ld(&bar[XB_TOPGEN]) == tg, bar);
            __builtin_amdgcn_fence(__ATOMIC_ACQUIRE, "agent");
            xb_add(&bar[XB_XGEN(b.x)], 1u);
            asm volatile("s_waitcnt vmcnt(0)" ::: "memory");
        } else {
            XB_SPIN(xb_ld(&bar[XB_XGEN(b.x)]) == gen, bar);
            __builtin_amdgcn_fence(__ATOMIC_ACQUIRE, "agent");
            asm volatile("s_waitcnt vmcnt(0)" ::: "memory");
        }
    }
    __syncthreads();
}


struct Frame {
    LAS unsigned char* lds;
    volatile LAS unsigned* MISC;
    gu32* ctl;
    int tid, lane, wave;
    int vcu, G;
    unsigned char* ws;
};
#define WSP(T, off) ((T*)(F.ws + (off)))

__device__ __forceinline__ float wave_sum(float v) {
#pragma unroll
    for (int o = 1; o < 64; o <<= 1) v += __shfl_xor(v, o);
    return v;
}
__device__ __forceinline__ void tr_item(const float* W, int ldw, int K, int c0, int nv, bf16* WT, int r0, int k0, const float* gain, LAS float* scr, int lane) {
#pragma unroll 8
    for (int i = 0; i < 32; ++i) { const int kk = 2 * i + (lane >> 5), n = lane & 31; float v = 0.f; if (n < nv) v = W[(size_t)(k0 + kk) * ldw + c0 + n]; if (gain) v *= gain[k0 + kk]; scr[kk * 33 + n] = v; }
    LDS_WAIT(); asm volatile("" ::: "memory");
    const int c = lane & 7;
#pragma unroll
    for (int j = 0; j < 4; ++j) { const int n = (lane >> 3) + 8 * j; const LAS float* s = scr + (8 * c) * 33 + n;
        v4u o; o.x = pk2(s[0 * 33], s[1 * 33]); o.y = pk2(s[2 * 33], s[3 * 33]); o.z = pk2(s[4 * 33], s[5 * 33]); o.w = pk2(s[6 * 33], s[7 * 33]);
        *(GAS v4u*)(WT + (size_t)(r0 + n) * K + k0 + 8 * c) = o; }
    LDS_WAIT(); asm volatile("" ::: "memory");
}
struct InPtrs { const float *x; const int* pos; const float *w_in, *qn, *kvn, *w_uq, *w_ukv, *w_a, *w_b, *w_out, *ln1g, *ln1b, *ffi, *ffd, *ln2g, *ln2b; };

__device__ __forceinline__ void p0_prologue(Frame& F, const InPtrs& I) {
    LAS float* scr = (LAS float*)(F.lds + RING_OFF + F.wave * 16384);
    const int gw = F.vcu * NWAVES + F.wave, NGW = F.G * NWAVES;
    constexpr int I_IN = (N_IN / 32) * (DM / 64), I_UQ = (768 / 32) * (256 / 64), I_UKV = (1024 / 32) * (256 / 64), I_A = (1024 / 32) * (512 / 64), I_B = I_A, I_OUT = (1024 / 32) * (1024 / 64),
                  I_FFI = (2 * DFF / 32) * (DM / 64), I_DN = (DM / 32) * (DFF / 64);
    constexpr int NITEMS = I_IN + I_UQ + I_UKV + I_A + I_B + I_OUT + I_FFI + I_DN;
    for (int it = gw; it < NITEMS; it += NGW) {
        int r = it;
        if (r < I_IN) { const int nb = r / (DM / 64), kb = r % (DM / 64), d = nb * 32; int c0 = 0, nv = 32;
            if (d < 512) c0 = d; else if (d < 1024) c0 = 544 + (d - 512); else if (d < 1536) c0 = 1056 + (d - 1024); else if (d < 2048) c0 = 1568 + (d - 1536); else if (d < 2304) c0 = 2080 + (d - 2048);
            else if (d < 3328) c0 = 2376 + (d - 2304); else if (d < 4352) c0 = 3400 + (d - 3328); else if (d == 4352) c0 = 512; else if (d == 4384) c0 = 2336; else if (d == 4416) { c0 = 2368; nv = 8; } else { c0 = 0; nv = 0; }
            tr_item(I.w_in, D_IN, DM, c0, nv, WSP(bf16, WS_W_IN), d, kb * 64, nullptr, scr, F.lane); continue; } r -= I_IN;
        if (r < I_UQ) { const int nb = r / 4, kb = r % 4; const int c0 = (nb < 16) ? (nb >> 1) * 96 + (nb & 1) * 32 : (nb - 16) * 96 + 64;
            tr_item(I.w_uq, 768, 256, c0, 32, WSP(bf16, WS_W_UQ), nb * 32, kb * 64, I.qn, scr, F.lane); continue; } r -= I_UQ;
        if (r < I_UKV) { const int nb = r / 4, kb = r % 4; const int c0 = (nb < 16) ? (nb >> 1) * 128 + (nb & 1) * 32 : ((nb - 16) >> 1) * 128 + 64 + ((nb - 16) & 1) * 32;
            tr_item(I.w_ukv, 1024, 256, c0, 32, WSP(bf16, WS_W_UKV), nb * 32, kb * 64, I.kvn, scr, F.lane); continue; } r -= I_UKV;
        if (r < I_A) { const int nb = r / 8, kb = r % 8; tr_item(I.w_a, 1024, 512, nb * 32, 32, WSP(bf16, WS_W_A), nb * 32, kb * 64, nullptr, scr, F.lane); continue; } r -= I_A;
        if (r < I_B) { const int nb = r / 8, kb = r % 8; tr_item(I.w_b, 1024, 512, nb * 32, 32, WSP(bf16, WS_W_B), nb * 32, kb * 64, nullptr, scr, F.lane); continue; } r -= I_B;
        if (r < I_OUT) { const int nb = r / 16, kb = r % 16; tr_item(I.w_out, 1024, 1024, nb * 32, 32, WSP(bf16, WS_W_OUT), nb * 32, kb * 64, nullptr, scr, F.lane); continue; } r -= I_OUT;
        if (r < I_FFI) { const int nb = r / 16, kb = r % 16; const int pn = nb >> 3, bj = (nb >> 2) & 1, q = nb & 3;
            tr_item(I.ffi, 2 * DFF, DM, bj * DFF + 128 * pn + 32 * q, 32, WSP(bf16, WS_W_FFI), nb * 32, kb * 64, nullptr, scr, F.lane); continue; } r -= I_FFI;
        { const int nb = r / (DFF / 64), kb = r % (DFF / 64); tr_item(I.ffd, DM, DFF, nb * 32, 32, WSP(bf16, WS_W_DN), nb * 32, kb * 64, nullptr, scr, F.lane); }
    }
    for (int m = gw; m < M; m += NGW) {
        const GAS f32x4* xr = (const GAS f32x4*)(I.x + (size_t)m * DM) + F.lane; GAS unsigned long long* o8 = (GAS unsigned long long*)(WSP(bf16, WS_XB) + (size_t)m * DM) + F.lane;
        f32x4 v[4];
#pragma unroll
        for (int j = 0; j < 4; ++j) v[j] = xr[64 * j];
#pragma unroll
        for (int j = 0; j < 4; ++j) o8[64 * j] = (unsigned long long)pk2(v[j].x, v[j].y) | ((unsigned long long)pk2(v[j].z, v[j].w) << 32);
    }
    for (int m4 = gw; m4 < M / 4; m4 += NGW) {
        const int m = m4 * 4 + (F.lane >> 4), i = F.lane & 15;
        const float invf = exp2f(-(float)i * (13.287712379549449f / 16.0f));
        const float ang = (float)I.pos[m] * invf;
        const double rev = (double)ang * 0.15915494309189535; const float fr = (float)(rev - rint(rev));
        WSP(float, WS_COS)[(size_t)m * 16 + i] = __builtin_amdgcn_cosf(fr); WSP(float, WS_SIN)[(size_t)m * 16 + i] = __builtin_amdgcn_sinf(fr);
    }
}

__device__ __forceinline__ void ln_rows(Frame& F, const float* src, const float* g, const float* bt, bf16* dbf, float* df) {
    const int gw = F.vcu * NWAVES + F.wave, NGW = F.G * NWAVES;
    f32x4 gv[4], bv[4];
#pragma unroll
    for (int j = 0; j < 4; ++j) { gv[j] = ((const GAS f32x4*)g)[F.lane + 64 * j]; bv[j] = ((const GAS f32x4*)bt)[F.lane + 64 * j]; }
    for (int m = gw; m < M; m += NGW) {
        const GAS f32x4* xr = (const GAS f32x4*)(src + (size_t)m * DM) + F.lane;
        f32x4 v[4]; float s = 0.f;
#pragma unroll
        for (int j = 0; j < 4; ++j) { v[j] = xr[64 * j]; s += (v[j].x + v[j].y) + (v[j].z + v[j].w); }
        const float mean = wave_sum(s) * (1.f / DM); float s2 = 0.f;
#pragma unroll
        for (int j = 0; j < 4; ++j) { v[j] = v[j] - mean; s2 += (v[j].x * v[j].x + v[j].y * v[j].y) + (v[j].z * v[j].z + v[j].w * v[j].w); }
        const float rstd = 1.f / sqrtf(wave_sum(s2) * (1.f / DM) + LN_EPS);
#pragma unroll
        for (int j = 0; j < 4; ++j) v[j] = v[j] * rstd * gv[j] + bv[j];
        if (dbf) { GAS unsigned long long* o8 = (GAS unsigned long long*)(dbf + (size_t)m * DM) + F.lane;
#pragma unroll
            for (int j = 0; j < 4; ++j) o8[64 * j] = (unsigned long long)pk2(v[j].x, v[j].y) | ((unsigned long long)pk2(v[j].z, v[j].w) << 32); }
        if (df) { GAS f32x4* o = (GAS f32x4*)(df + (size_t)m * DM) + F.lane;
#pragma unroll
            for (int j = 0; j < 4; ++j) o[64 * j] = v[j]; }
    }
}

__device__ __forceinline__ float relu_(float x) { return __builtin_amdgcn_fmed3f(x, 0.f, __builtin_inff()); }
#define WRLANE(w, sval, ln) asm volatile("s_nop 1\n\tv_writelane_b32 %0, %1, %2" : "+v"(w) : "s"(__builtin_amdgcn_readfirstlane((int)(sval))), "i"(ln))
__device__ __forceinline__ void idx_task(Frame& F, int b, int qt, const LAS unsigned char* kl, LAS unsigned* hist) {
    int lane_ = F.lane; asm volatile("" : "+v"(lane_));
    const int lane = lane_, hi = lane >> 5, j = lane & 31, wid = F.wave;
    const int t0 = 32 * qt + 4 * wid; const size_t rowbase = (size_t)b * SEQ;
    unsigned W[4] = {0u, 0u, 0u, 0u};
#ifdef DBG_TRIVIAL_MASK
    if (true) {
#else
    if (qt < 8) {
#endif
#pragma unroll
        for (int lq = 0; lq < 4; ++lq) { const int t = t0 + lq, wb = t >> 5; W[lq] = lane < wb ? 0xffffffffu : (lane == wb ? ((2u << (t & 31)) - 1u) : 0u); }
    } else {
        const int hi_i = (j >> 2) & 1, qq_i = (j >> 4) & 1, head_i = ((j >> 3) & 1) * 4 + (j & 3), lq_i = 2 * hi_i + qq_i;
        const bf16* qsrc = WSP(bf16, WS_QI) + (rowbase + t0 + lq_i) * 256 + head_i * 32 + hi * 8;
        const bf16x8 a0 = *(const GAS bf16x8*)qsrc, a1 = *(const GAS bf16x8*)(qsrc + 16);
        float w[2][8];
#pragma unroll
        for (int qq = 0; qq < 2; ++qq) { const float* wp = WSP(float, WS_WI) + (rowbase + t0 + 2 * hi + qq) * 8; const f32x4 x = *(const GAS f32x4*)wp, y = *(const GAS f32x4*)(wp + 4);
            w[qq][0] = x.x; w[qq][1] = x.y; w[qq][2] = x.z; w[qq][3] = x.w; w[qq][4] = y.x; w[qq][5] = y.y; w[qq][6] = y.z; w[qq][7] = y.w; }
        unsigned sc[2][64];
        const int jlim = 4 * wid + 2 * hi, sw = j & 3;
        const LAS unsigned char* kp0 = kl + j * 64 + ((hi ^ sw) << 4);
        const LAS unsigned char* kp1 = kl + j * 64 + (((2 + hi) ^ sw) << 4);
#pragma unroll
        for (int kb = 0; kb < 64; ++kb) {
            if (kb <= qt) {
                const bf16x8 b0 = *(const LAS bf16x8*)(kp0 + kb * 2048), b1 = *(const LAS bf16x8*)(kp1 + kb * 2048);
                att::f32x16 acc = att::f32x16{};
                acc = __builtin_amdgcn_mfma_f32_32x32x16_bf16(a0, b0, acc, 0, 0, 0);
                acc = __builtin_amdgcn_mfma_f32_32x32x16_bf16(a1, b1, acc, 0, 0, 0);
#pragma unroll
                for (int qq = 0; qq < 2; ++qq) { float s = 0.f;
#pragma unroll
                    for (int h = 0; h < 8; ++h) s = fmaf(w[qq][h], relu_(acc[8 * qq + h]), s);
                    const unsigned u = __float_as_uint(s); unsigned k32 = (u & 0x80000000u) ? ~u : (u | 0x80000000u);
                    if (kb == qt) { if (j > jlim + qq) k32 = 0u; }
                    sc[qq][kb] = k32; }
                asm volatile("" : "+v"(sc[0][kb]), "+v"(sc[1][kb])); __builtin_amdgcn_sched_barrier(0);
            } else { sc[0][kb] = 0u; sc[1][kb] = 0u; }
        }
        unsigned pref[4] = {0u, 0u, 0u, 0u}, rem[4] = {256u, 256u, 256u, 256u}, cnteq[4] = {0u, 0u, 0u, 0u};
        LAS unsigned* hq[2] = {hist + (2 * hi) * 128, hist + (2 * hi + 1) * 128};
        for (int pass = 0; pass < 4; ++pass) {
            const int shift = 24 - 8 * pass;
            *(LAS v4u*)(hist + lane * 8) = (v4u){0u, 0u, 0u, 0u}; *(LAS v4u*)(hist + lane * 8 + 4) = (v4u){0u, 0u, 0u, 0u};
            const unsigned pv0 = hi ? pref[2] : pref[0], pv1 = hi ? pref[3] : pref[1];
#pragma unroll
            for (int kb = 0; kb < 64; ++kb) {
                if (kb <= qt) {
#pragma unroll
                    for (int qq = 0; qq < 2; ++qq) { const unsigned k = sc[qq][kb]; const unsigned d = (k >> shift) & 255u; const unsigned up = (pass == 0) ? 0u : (k >> (shift + 8));
                        if (up == (qq ? pv1 : pv0)) __hip_atomic_fetch_add(hq[qq] + (d >> 1), 1u << ((d & 1u) * 16u), __ATOMIC_RELAXED, __HIP_MEMORY_SCOPE_WORKGROUP); }
                }
            }
#pragma unroll
            for (int lq = 0; lq < 4; ++lq) {
                const u32x2v wv = *(const LAS u32x2v*)(hist + lq * 128 + lane * 2);
                const unsigned c0 = wv.x & 0xffffu, c1 = wv.x >> 16, c2 = wv.y & 0xffffu, c3 = wv.y >> 16, s = c0 + c1 + c2 + c3;
                unsigned S = s;
#pragma unroll
                for (int off = 1; off < 64; off <<= 1) { const unsigned tt = __shfl_down(S, off); if (lane + off < 64) S += tt; }
                const unsigned rm = rem[lq], above0 = S - s;
                const unsigned long long bal = __ballot((S >= rm) && (above0 < rm));
                const int L = __builtin_amdgcn_readfirstlane((int)__builtin_ctzll(bal | (1ull << 63)));
                unsigned a = above0, dsub, ceq;
                if (a + c3 >= rm) { dsub = 3u; ceq = c3; } else { a += c3; if (a + c2 >= rm) { dsub = 2u; ceq = c2; } else { a += c2; if (a + c1 >= rm) { dsub = 1u; ceq = c1; } else { a += c1; dsub = 0u; ceq = c0; } } }
                const unsigned digit = (unsigned)__builtin_amdgcn_readlane((int)(4u * (unsigned)lane + dsub), L);
                const unsigned aa = (unsigned)__builtin_amdgcn_readlane((int)a, L), ce = (unsigned)__builtin_amdgcn_readlane((int)ceq, L);
                pref[lq] = (pref[lq] << 8) | digit; rem[lq] = rm - aa; cnteq[lq] = ce;
            }
        }
        const bool ties = (rem[0] < cnteq[0]) || (rem[1] < cnteq[1]) || (rem[2] < cnteq[2]) || (rem[3] < cnteq[3]);
        const unsigned th0 = hi ? pref[2] : pref[0], th1 = hi ? pref[3] : pref[1];
        if (!ties) {
#pragma unroll
            for (int kb = 0; kb < 64; ++kb) {
                if (kb <= qt) {
                    const unsigned long long b0 = __ballot(sc[0][kb] >= th0), b1 = __ballot(sc[1][kb] >= th1);
                    WRLANE(W[0], (unsigned)b0, kb); WRLANE(W[2], (unsigned)(b0 >> 32), kb);
                    WRLANE(W[1], (unsigned)b1, kb); WRLANE(W[3], (unsigned)(b1 >> 32), kb);
                }
            }
        } else {
            const unsigned rm0 = hi ? rem[2] : rem[0], rm1 = hi ? rem[3] : rem[1];
            unsigned run0 = 0u, run1 = 0u;
#pragma unroll
            for (int kb = 0; kb < 64; ++kb) {
                if (kb <= qt) {
#pragma unroll
                    for (int qq = 0; qq < 2; ++qq) { const unsigned k = sc[qq][kb], th = qq ? th1 : th0, rmq = qq ? rm1 : rm0; unsigned& run = qq ? run1 : run0;
                        const bool eq = (k == th); const unsigned long long be = __ballot(eq);
                        const unsigned rl = __builtin_amdgcn_mbcnt_lo((unsigned)be, 0u), rh = __builtin_amdgcn_mbcnt_hi((unsigned)(be >> 32), 0u);
                        const unsigned rank = run + (hi ? rh : rl);
                        const bool sel = (k > th) || (eq && rank < rmq);
                        run += hi ? (unsigned)__builtin_popcount((unsigned)(be >> 32)) : (unsigned)__builtin_popcount((unsigned)be);
                        const unsigned long long bs = __ballot(sel);
                        WRLANE(W[qq], (unsigned)bs, kb); WRLANE(W[2 + qq], (unsigned)(bs >> 32), kb); }
                }
            }
        }
    }
    unsigned* mk = WSP(unsigned, WS_MASK) + (rowbase + t0) * 64 + lane;
#pragma unroll
    for (int lq = 0; lq < 4; ++lq) mk[lq * 64] = W[lq];
}
__device__ __forceinline__ void idx_phase(Frame& F) {
    const int b = F.vcu >> 3, sub = F.vcu & 7;
    LAS unsigned char* kl = F.lds + RING_OFF; LAS unsigned* hist = (LAS unsigned*)(F.lds + RING_OFF + 131072) + F.wave * 512;
    const bf16* kib = WSP(bf16, WS_KI) + (size_t)b * SEQ * 32;
    for (int i = F.tid; i < SEQ * 4; i += NWAVES * 64) { const int key = i >> 2, c = i & 3; const v4u v = *(const GAS v4u*)(kib + key * 32 + c * 8); *(LAS v4u*)(kl + key * 64 + ((c ^ (key & 3)) << 4)) = v; }
    __syncthreads();
    for (int k = 0; k < 4; ++k) { const int q = sub + 8 * k; idx_task(F, b, q, kl, hist); idx_task(F, b, 63 - q, kl, hist); }
    __syncthreads();
}

struct Args { InPtrs in; float* out; unsigned char* ws; int ph_lo, ph_hi; };
__global__ void __launch_bounds__(NWAVES * 64, 2) hybrid_fwd(Args args) {
    extern __shared__ __attribute__((aligned(16))) unsigned char lds[];
    Frame F;
    F.lds = (LAS unsigned char*)lds;
    F.MISC = (volatile LAS unsigned*)(F.lds + MISC_OFF);
    F.tid = threadIdx.x; F.lane = F.tid & 63; F.wave = __builtin_amdgcn_readfirstlane(F.tid >> 6);
    F.G = gridDim.x; { const int bx = blockIdx.x; F.vcu = (F.G % 8 == 0) ? (bx % 8) * (F.G / 8) + bx / 8 : bx; }
    F.ws = args.ws; F.ctl = (gu32*)(args.ws + WS_CTL);
    const InPtrs& I = args.in;
    for (int u = F.tid; u < (LDS_BYTES - LDSCTL_OFF) / 4; u += NWAVES * 64) ((LAS unsigned*)(F.lds + LDSCTL_OFF))[u] = 0u;
    __syncthreads();
    XcdBarrier bar; bar.bar = (unsigned*)(F.ctl + CW_BAR); bar.x = 0; bar.st = nullptr;
    if (N_LAUNCHES == 1) bar = xcd_barrier_post((unsigned*)(F.ctl + CW_BAR), F.MISC + 8);
#define GRID_BAR() do { if (N_LAUNCHES == 1) xcd_barrier(bar); } while (0)
    const int lo = args.ph_lo, hi = args.ph_hi;
#define IN(k) (lo <= (k) && (k) < hi)
#define BOTH(k) (IN(k) && IN((k) + 1))
    using pg8::bf16_t;

#ifndef PH_MASK
#define PH_MASK 0xFFF
#endif
#define PHON(k) ((PH_MASK >> (k)) & 1)
    if (PHON(0) && IN(0)) { p0_prologue(F, I); if (BOTH(0)) GRID_BAR(); }

    if (PHON(1) && IN(1)) {
        pg8::Gemm g{WSP(bf16_t, WS_XB), WSP(bf16_t, WS_W_IN), M, N_IN, DM, DM, DM}; pg8::StaticOrder S; S.init(M, N_IN, F.G, (int)blockIdx.x);
        pg8::EpiIn E{WSP(bf16_t, WS_CQ), WSP(bf16_t, WS_CKV), WSP(bf16_t, WS_QB), WSP(bf16_t, WS_KB), WSP(bf16_t, WS_VB), WSP(bf16_t, WS_QI), WSP(bf16_t, WS_SGA), WSP(bf16_t, WS_SGB), WSP(bf16_t, WS_KMLA), WSP(bf16_t, WS_KI),
                     WSP(float, WS_WI), WSP(float, WS_SSQ_Q), WSP(float, WS_SSQ_KV), WSP(float, WS_COS), WSP(float, WS_SIN)};
        pg8::gemm_phase<pg8::EpiIn, pg8::StaticOrder, true>(F.lds + RING_OFF, g, S, E);
        if (BOTH(1)) GRID_BAR();
    }
    if (PHON(2) && IN(2)) {
#ifndef NO_UQ
        { pg8::Gemm g{WSP(bf16_t, WS_CQ), WSP(bf16_t, WS_W_UQ), M, 768, 256, 256, 256}; pg8::StaticOrder S; S.init(M, 768, F.G, (int)blockIdx.x);
          pg8::EpiUq E{WSP(bf16_t, WS_QMLA), WSP(float, WS_SSQ_Q), WSP(float, WS_COS), WSP(float, WS_SIN)};
          pg8::gemm_phase<pg8::EpiUq, pg8::StaticOrder, true>(F.lds + RING_OFF, g, S, E); }
        __syncthreads();
#endif
#ifndef NO_UKV
        { pg8::Gemm g{WSP(bf16_t, WS_CKV), WSP(bf16_t, WS_W_UKV), M, 1024, 256, 256, 256}; pg8::StaticOrder S; S.init(M, 1024, F.G, (int)blockIdx.x);
          pg8::EpiUkv E{WSP(bf16_t, WS_KMLA), WSP(bf16_t, WS_VA), WSP(float, WS_SSQ_KV)};
          pg8::gemm_phase<pg8::EpiUkv, pg8::StaticOrder, true>(F.lds + RING_OFF, g, S, E); }
#endif
        if (BOTH(2)) GRID_BAR();
    }
    if (PHON(3) && IN(3)) {
        if (F.G == 256) {
#ifndef NO_IDX
            idx_phase(F);
#endif
#ifndef NO_MLA
            const att::AttnArgs T{WSP(att::bf16, WS_QMLA), 768, WSP(att::bf16, WS_KMLA), 768, WSP(att::bf16, WS_VA), 512, WSP(att::bf16, WS_OA), 512, 0, nullptr};
            const int b = F.vcu >> 3, h = F.vcu & 7;
            for (int i = 0; i < 8; ++i) att::attn_unit<6, false>(b, h, 7 - i, T, 0.f, (att::LDSC*)(F.lds + RING_OFF));
#endif
        }
        if (BOTH(3)) GRID_BAR();
    }
    if (PHON(4) && IN(4)) {
        if (F.G == 256) {
            const att::AttnArgs T{WSP(att::bf16, WS_QB), 512, WSP(att::bf16, WS_KB), 512, WSP(att::bf16, WS_VB), 512, WSP(att::bf16, WS_OB), 512, 0, WSP(unsigned, WS_MASK)};
            const int b = F.vcu >> 3, h = F.vcu & 7; const float slope2 = exp2f(-(float)(h + 1)) * LOG2E;
            for (int i = 0; i < 8; ++i) att::attn_unit<4, true>(b, h, 7 - i, T, slope2, (att::LDSC*)(F.lds + RING_OFF));
        }
        if (BOTH(4)) GRID_BAR();
    }
    if (PHON(5) && IN(5)) {
        pg8::Gemm g{WSP(bf16_t, WS_OA), WSP(bf16_t, WS_W_A), M, 1024, 512, 512, 512}; pg8::StaticOrder S; S.init(M, 1024, F.G, (int)blockIdx.x);
        pg8::EpiGate<false> E{WSP(bf16_t, WS_SGA), nullptr, WSP(bf16_t, WS_TA)};
        pg8::gemm_phase<pg8::EpiGate<false>, pg8::StaticOrder, true>(F.lds + RING_OFF, g, S, E);
        if (BOTH(5)) GRID_BAR();
    }
    if (PHON(6) && IN(6)) {
        pg8::Gemm g{WSP(bf16_t, WS_OB), WSP(bf16_t, WS_W_B), M, 1024, 512, 512, 512}; pg8::StaticOrder S; S.init(M, 1024, F.G, (int)blockIdx.x);
        pg8::EpiGate<true> E{WSP(bf16_t, WS_SGB), WSP(bf16_t, WS_TA), WSP(bf16_t, WS_MIXED)};
        pg8::gemm_phase<pg8::EpiGate<true>, pg8::StaticOrder, true>(F.lds + RING_OFF, g, S, E);
        if (BOTH(6)) GRID_BAR();
    }
    if (PHON(7) && IN(7)) {
        pg8::Gemm g{WSP(bf16_t, WS_MIXED), WSP(bf16_t, WS_W_OUT), M, 1024, 1024, 1024, 1024}; pg8::StaticOrder S; S.init(M, 1024, F.G, (int)blockIdx.x);
        pg8::EpiResF32 E{I.x, args.out};
        pg8::gemm_phase<pg8::EpiResF32, pg8::StaticOrder, true>(F.lds + RING_OFF, g, S, E);
        if (BOTH(7)) GRID_BAR();
    }
    if (PHON(8) && IN(8)) { ln_rows(F, args.out, I.ln1g, I.ln1b, WSP(bf16, WS_H1), nullptr); if (BOTH(8)) GRID_BAR(); }
    if (PHON(9) && IN(9)) {
        pg8::Gemm g{WSP(bf16_t, WS_H1), WSP(bf16_t, WS_W_FFI), M, 2 * DFF, DM, DM, DM}; pg8::StaticOrder S; S.init(M, 2 * DFF, F.G, (int)blockIdx.x);
        pg8::EpiSwiglu E{WSP(bf16_t, WS_ACT)};
        pg8::gemm_phase<pg8::EpiSwiglu, pg8::StaticOrder, true>(F.lds + RING_OFF, g, S, E);
        if (BOTH(9)) GRID_BAR();
    }
    if (PHON(10) && IN(10)) {
        pg8::Gemm g{WSP(bf16_t, WS_ACT), WSP(bf16_t, WS_W_DN), M, DM, DFF, DFF, DFF}; pg8::StaticOrder S; S.init(M, DM, F.G, (int)blockIdx.x);
        pg8::EpiResBf E{WSP(bf16_t, WS_H1), args.out};
        pg8::gemm_phase<pg8::EpiResBf, pg8::StaticOrder, true>(F.lds + RING_OFF, g, S, E);
        if (BOTH(10)) GRID_BAR();
    }
    if (PHON(11) && IN(11)) { ln_rows(F, args.out, I.ln2g, I.ln2b, nullptr, args.out); }
#undef IN
#undef BOTH
#undef GRID_BAR
}

extern "C" void kernel_launch(void* const* d_in, const int* in_sizes, int n_in, void* d_out, int out_size, void* d_ws, size_t ws_size, hipStream_t stream) {
    static int grid = 0;
    if (grid == 0) {
        if (n_in != 16 || in_sizes[0] != M * DM || out_size != M * DM || ws_size < WS_END) { fprintf(stderr, "kernel_launch: unexpected sizes (n_in %d, in0 %d, out %d, ws %zu < %zu); nothing launched\n", n_in, n_in > 0 ? in_sizes[0] : -1, out_size, ws_size, (size_t)WS_END); grid = -1; return; }
        int dev = 0, cus = 0, per_cu = 0;
        if (hipGetDevice(&dev) != hipSuccess || hipDeviceGetAttribute(&cus, hipDeviceAttributeMultiprocessorCount, dev) != hipSuccess) { grid = -1; return; }
        if (hipFuncSetAttribute((const void*)hybrid_fwd, hipFuncAttributeMaxDynamicSharedMemorySize, LDS_BYTES) != hipSuccess) { fprintf(stderr, "kernel_launch: hipFuncSetAttribute failed\n"); grid = -1; return; }
        if (hipOccupancyMaxActiveBlocksPerMultiprocessor(&per_cu, (const void*)hybrid_fwd, NWAVES * 64, LDS_BYTES) != hipSuccess || per_cu < 1) { fprintf(stderr, "kernel_launch: occupancy query reports %d workgroups per CU\n", per_cu); }
        (void)hipGetLastError();
        grid = cus;
    }
    if (grid < 0) return;
    if (hipMemsetAsync((char*)d_ws + WS_CTL, 0, CTL_ZERO_BYTES, stream) != hipSuccess) return;
#if PH_MASK_DBG_ZERO_O
    hipMemsetAsync((char*)d_ws + WS_OA, 0, 64 * MiB, stream); hipMemsetAsync((char*)d_ws + WS_OB, 0, 64 * MiB, stream);
#endif
    Args a{};
    a.in.x = (const float*)d_in[0]; a.in.pos = (const int*)d_in[1]; a.in.w_in = (const float*)d_in[2]; a.in.qn = (const float*)d_in[3]; a.in.kvn = (const float*)d_in[4];
    a.in.w_uq = (const float*)d_in[5]; a.in.w_ukv = (const float*)d_in[6]; a.in.w_a = (const float*)d_in[7]; a.in.w_b = (const float*)d_in[8]; a.in.w_out = (const float*)d_in[9];
    a.in.ln1g = (const float*)d_in[10]; a.in.ln1b = (const float*)d_in[11]; a.in.ffi = (const float*)d_in[12]; a.in.ffd = (const float*)d_in[13]; a.in.ln2g = (const float*)d_in[14]; a.in.ln2b = (const float*)d_in[15];
    a.out = (float*)d_out; a.ws = (unsigned char*)d_ws;
    for (int li = 0; li < N_LAUNCHES; ++li) {
        a.ph_lo = (N_LAUNCHES == PER_PHASE) ? li : 0; a.ph_hi = (N_LAUNCHES == PER_PHASE) ? li + 1 : PER_PHASE;
        hipLaunchKernelGGL(hybrid_fwd, dim3(grid), dim3(NWAVES * 64), LDS_BYTES, stream, a);
        if (hipPeekAtLastError() != hipSuccess) { fprintf(stderr, "kernel_launch: launch %d failed\n", li); break; }
    }
}
```

```cpp
#include <hip/hip_runtime.h>
#include <hip/hip_bf16.h>
#include <cstdio>
#include <cstdint>
#include <cmath>

constexpr int BATCH = 32, SEQ = 2048, DM = 1024, M = BATCH * SEQ;
constexpr int D_IN = 4424, N_IN = 4608;
constexpr int DFF = 2816;
constexpr float ALPHA = 1.189207115002721f;
constexpr float LN_EPS = 1e-5f, RMS_EPS = 1e-6f;
constexpr float LOG2E = 1.4426950408889634f;
constexpr float QSCALE_MLA = 0.10206207261596575f * LOG2E;
constexpr float QSCALE_DSA = 0.125f * LOG2E;
constexpr float IDX_SCALE = 0.0625f;

namespace pg8 {
#define PG8_LAS __attribute__((address_space(3)))
typedef unsigned short bf16_t;
typedef short bf16x8 __attribute__((ext_vector_type(8)));
typedef float f32x4 __attribute__((ext_vector_type(4)));
typedef unsigned u32x4 __attribute__((ext_vector_type(4)));
constexpr int BM = 256, BK = 64, HALF = 128, HTB = HALF * BK * 2  , STAGE_BYTES = 8 * HTB, NXCD = 8, WGM = 8;

__host__ __device__ __forceinline__ int lds_byte(int r, int c) { const int st = (r >> 4) * 2 + (c >> 5), rr = r & 15, cc = c & 31, ob = rr * 64 + cc * 2; return st * 1024 + (ob ^ (((ob >> 9) & 1) << 5)); }
__host__ __device__ __forceinline__ void stage_rc(int b, int& R, int& C) { const int st = b / 1024, sb = b % 1024, swz = sb ^ (((sb >> 9) & 1) << 5); R = (st >> 1) * 16 + swz / 64; C = (st & 1) * 32 + (swz % 64) / 2; }
__host__ __device__ __forceinline__ int perm32(int rho) { const int n = rho >> 4, i = rho & 15; return 8 * (i >> 2) + 4 * n + (i & 3); }

struct Unit { int pm, pn; };
struct Gemm { const bf16_t* A; const bf16_t* Bt; int M, N, K, lda, ldb; };

struct StaticOrder {
    int nM, nN, nwg, G, c;
    __host__ __device__ void init(int M, int N, int G_, int c_) { nM = M / BM; nN = N / BM; nwg = nM * nN; G = G_; c = c_; }
    __host__ __device__ bool next(int i, Unit& u) const {
        const long L = (long)i * G + c; if (L >= nwg) return false;
        int wgid = (int)L; { const int q = nwg / NXCD, r = nwg % NXCD, xcd = wgid % NXCD, off = wgid / NXCD; wgid = (xcd < r ? xcd * (q + 1) : r * (q + 1) + (xcd - r) * q) + off; }
        const int nig = WGM * nN, gid = wgid / nig, fm = gid * WGM, gsz = (nM - fm) < WGM ? (nM - fm) : WGM;
        u.pm = fm + ((wgid % nig) % gsz); u.pn = (wgid % nig) / gsz; return true;
    }
    __device__ __forceinline__ void a_ready(const Unit&) const {}
    __device__ __forceinline__ void done(const Unit&) const {}
};

__device__ __forceinline__ unsigned cvt_pk_bf16(float lo, float hi) { unsigned r; asm volatile("v_cvt_pk_bf16_f32 %0, %1, %2" : "=v"(r) : "v"(lo), "v"(hi)); return r; }
typedef float f32x2 __attribute__((ext_vector_type(2)));
typedef unsigned u32x2 __attribute__((ext_vector_type(2)));
__device__ __forceinline__ float bf_lo(unsigned u) { return __uint_as_float(u << 16); }
__device__ __forceinline__ float bf_hi(unsigned u) { return __uint_as_float(u & 0xffff0000u); }
__device__ __forceinline__ float sigmoidf_(float v) { return __builtin_amdgcn_rcpf(1.0f + __builtin_amdgcn_exp2f(-v * LOG2E)); }
__device__ __forceinline__ u32x4 pack8(const f32x4 v0, const f32x4 v1) { u32x4 w; w.x = cvt_pk_bf16(v0[0], v0[1]); w.y = cvt_pk_bf16(v0[2], v0[3]); w.z = cvt_pk_bf16(v1[0], v1[1]); w.w = cvt_pk_bf16(v1[2], v1[3]); return w; }
__device__ __forceinline__ void rope8(f32x4& v0, f32x4& v1, const float* cs, const float* sn, unsigned row, int fq) {
    const f32x4 c0 = *(const f32x4*)(cs + row * 16 + 8 * (fq & 1)), c1 = *(const f32x4*)(cs + row * 16 + 8 * (fq & 1) + 4);
    const f32x4 s0 = *(const f32x4*)(sn + row * 16 + 8 * (fq & 1)), s1 = *(const f32x4*)(sn + row * 16 + 8 * (fq & 1) + 4);
    const float sg = (fq < 2) ? -1.f : 1.f;
#pragma unroll
    for (int e = 0; e < 4; ++e) { const float p0 = __shfl_xor(v0[e], 32), p1 = __shfl_xor(v1[e], 32);
        v0[e] = v0[e] * c0[e] + sg * p0 * s0[e]; v1[e] = v1[e] * c1[e] + sg * p1 * s1[e]; }
}

struct EpiIn {
    static constexpr bool PERM = true, AFTER_DRAIN = false, HAS_MID = false;
    bf16_t *cq, *ckv, *qb, *kb, *vb, *qi, *sga, *sgb, *kmla, *ki; float *wi, *ssq_q, *ssq_kv; const float *cs, *sn;
    __device__ __forceinline__ void operator()(const f32x4 (&acc)[2][2][4][2], const Unit& u, int wr, int wc, int fr, int fq) const {
        const int pn = u.pn; unsigned row0 = (unsigned)(u.pm * BM + wr * 64 + fr); asm volatile("" : "+v"(row0));
#ifdef DBG_NOEPI
        return;
#endif
        if (pn < 17) {
            bf16_t* base; int ld, colt, mode = 0; float sc = 1.f; float* ssq = nullptr;
            if (pn == 0) { base = cq; ld = 256; colt = 0; ssq = ssq_q; }
            else if (pn == 1) { base = ckv; ld = 256; colt = 0; ssq = ssq_kv; }
            else if (pn < 4) { base = qb; ld = 512; colt = (pn - 2) * 256; sc = QSCALE_DSA; }
            else if (pn < 6) { base = kb; ld = 512; colt = (pn - 4) * 256; }
            else if (pn < 8) { base = vb; ld = 512; colt = (pn - 6) * 256; }
            else if (pn == 8) { base = qi; ld = 256; colt = 0; }
            else if (pn < 13) { base = sga; ld = 1024; colt = (pn - 9) * 256; mode = 1; }
            else { base = sgb; ld = 1024; colt = (pn - 13) * 256; mode = 1; }
            const int col0 = colt + wc * 32 + 8 * fq;
#pragma unroll
            for (int ai = 0; ai < 2; ++ai)
#pragma unroll
                for (int m = 0; m < 4; ++m) { const unsigned row = row0 + (unsigned)(ai * HALF + m * 16); bf16_t* rowp = base + row * ld + col0; float q = 0.f;
#pragma unroll
                    for (int bj = 0; bj < 2; ++bj) { f32x4 v0 = acc[ai][bj][m][0], v1 = acc[ai][bj][m][1];
                        q += (v0[0] * v0[0] + v0[1] * v0[1]) + (v0[2] * v0[2] + v0[3] * v0[3]) + (v1[0] * v1[0] + v1[1] * v1[1]) + (v1[2] * v1[2] + v1[3] * v1[3]);
                        if (mode == 1) {
#pragma unroll
                            for (int e = 0; e < 4; ++e) { v0[e] = sigmoidf_(v0[e]); v1[e] = sigmoidf_(v1[e]); } }
                        else { v0 = v0 * sc; v1 = v1 * sc; }
                        *(u32x4*)(rowp + bj * HALF) = pack8(v0, v1); }
                    if (ssq) { q += __shfl_xor(q, 16); q += __shfl_xor(q, 32); if (fq == 0) ssq[row * 4 + wc] = q; } }
        } else {
            if (wc == 0) {
#pragma unroll
                for (int ai = 0; ai < 2; ++ai)
#pragma unroll
                    for (int m = 0; m < 4; ++m) { const unsigned row = row0 + (unsigned)(ai * HALF + m * 16); f32x4 v0 = acc[ai][0][m][0], v1 = acc[ai][0][m][1];
                        rope8(v0, v1, cs, sn, row, fq); const u32x4 w = pack8(v0, v1); bf16_t* kp = kmla + row * 768 + 64 + 8 * fq;
#pragma unroll
                        for (int h = 0; h < 8; ++h) *(u32x4*)(kp + h * 96) = w;
                        asm volatile("" ::: "memory"); }
            } else if (wc == 1) {
#pragma unroll
                for (int ai = 0; ai < 2; ++ai)
#pragma unroll
                    for (int m = 0; m < 4; ++m) { const unsigned row = row0 + (unsigned)(ai * HALF + m * 16); *(u32x4*)(ki + row * 32 + 8 * fq) = pack8(acc[ai][0][m][0], acc[ai][0][m][1]); }
            } else if (wc == 2) {
                if (fq == 0) {
#pragma unroll
                    for (int ai = 0; ai < 2; ++ai)
#pragma unroll
                        for (int m = 0; m < 4; ++m) { const unsigned row = row0 + (unsigned)(ai * HALF + m * 16); *(f32x4*)(wi + row * 8) = acc[ai][0][m][0] * IDX_SCALE; *(f32x4*)(wi + row * 8 + 4) = acc[ai][0][m][1] * IDX_SCALE; } }
            }
        }
    }
};

struct EpiUq {
    static constexpr bool PERM = true, AFTER_DRAIN = false, HAS_MID = false;
    bf16_t* qm; const float* ssq; const float *cs, *sn;
    __device__ __forceinline__ void operator()(const f32x4 (&acc)[2][2][4][2], const Unit& u, int wr, int wc, int fr, int fq) const {
        const int pn = u.pn; unsigned row0 = (unsigned)(u.pm * BM + wr * 64 + fr); asm volatile("" : "+v"(row0));
#pragma unroll
        for (int ai = 0; ai < 2; ++ai)
#pragma unroll
            for (int m = 0; m < 4; ++m) { const unsigned row = row0 + (unsigned)(ai * HALF + m * 16); const f32x4 p = *(const f32x4*)(ssq + row * 4);
                const float sc = QSCALE_MLA * __builtin_amdgcn_rsqf(((p[0] + p[1]) + (p[2] + p[3])) * (1.0f / 256.0f) + RMS_EPS);
#pragma unroll
                for (int bj = 0; bj < 2; ++bj) { f32x4 v0 = acc[ai][bj][m][0] * sc, v1 = acc[ai][bj][m][1] * sc;
                    if (pn < 2) { const int c = pn * 256 + bj * HALF + wc * 32 + 8 * fq; *(u32x4*)(qm + row * 768 + (c >> 6) * 96 + (c & 63)) = pack8(v0, v1); }
                    else { rope8(v0, v1, cs, sn, row, fq); const int h = bj * 4 + wc; *(u32x4*)(qm + row * 768 + h * 96 + 64 + 8 * fq) = pack8(v0, v1); } }
                asm volatile("" ::: "memory"); }
    }
};
struct EpiUkv {
    static constexpr bool PERM = true, AFTER_DRAIN = false, HAS_MID = false;
    bf16_t *km, *va; const float* ssq;
    __device__ __forceinline__ void operator()(const f32x4 (&acc)[2][2][4][2], const Unit& u, int wr, int wc, int fr, int fq) const {
        const int pn = u.pn; unsigned row0 = (unsigned)(u.pm * BM + wr * 64 + fr); asm volatile("" : "+v"(row0));
#pragma unroll
        for (int ai = 0; ai < 2; ++ai)
#pragma unroll
            for (int m = 0; m < 4; ++m) { const unsigned row = row0 + (unsigned)(ai * HALF + m * 16); const f32x4 p = *(const f32x4*)(ssq + row * 4);
                const float sc = __builtin_amdgcn_rsqf(((p[0] + p[1]) + (p[2] + p[3])) * (1.0f / 256.0f) + RMS_EPS);
#pragma unroll
                for (int bj = 0; bj < 2; ++bj) { const f32x4 v0 = acc[ai][bj][m][0] * sc, v1 = acc[ai][bj][m][1] * sc; const int c = (pn & 1) * 256 + bj * HALF + wc * 32 + 8 * fq;
                    if (pn < 2) *(u32x4*)(km + row * 768 + (c >> 6) * 96 + (c & 63)) = pack8(v0, v1);
                    else *(u32x4*)(va + row * 512 + c) = pack8(v0, v1); }
                asm volatile("" ::: "memory"); }
    }
};
struct EpiGate2 {
    static constexpr bool PERM = true, AFTER_DRAIN = false, HAS_MID = true;
    const bf16_t *sga, *sgb; bf16_t* out;
    static __device__ __forceinline__ float fl(float v) { return fmaxf(v, 8.6736174e-19f); }
    __device__ __forceinline__ void mid(f32x4 (&acc)[2][2][4][2], const Unit& u, int wr, int wc, int fr, int fq) const {
        unsigned row0 = (unsigned)(u.pm * BM + wr * 64 + fr); asm volatile("" : "+v"(row0));     const int col0 = u.pn * BM + wc * 32 + 8 * fq;
#pragma unroll
        for (int ai = 0; ai < 2; ++ai)
#pragma unroll
            for (int m = 0; m < 4; ++m) { const unsigned off = (row0 + (unsigned)(ai * HALF + m * 16)) * 1024u + (unsigned)col0;
#pragma unroll
                for (int bj = 0; bj < 2; ++bj) { const u32x4 a = *(const u32x4*)(sga + off + bj * HALF), b = *(const u32x4*)(sgb + off + bj * HALF);
                    f32x4& v0 = acc[ai][bj][m][0]; f32x4& v1 = acc[ai][bj][m][1];
                    v0[0] *= bf_lo(a.x) * __builtin_amdgcn_rcpf(fl(bf_lo(b.x))); v0[1] *= bf_hi(a.x) * __builtin_amdgcn_rcpf(fl(bf_hi(b.x))); v0[2] *= bf_lo(a.y) * __builtin_amdgcn_rcpf(fl(bf_lo(b.y))); v0[3] *= bf_hi(a.y) * __builtin_amdgcn_rcpf(fl(bf_hi(b.y)));
                    v1[0] *= bf_lo(a.z) * __builtin_amdgcn_rcpf(fl(bf_lo(b.z))); v1[1] *= bf_hi(a.z) * __builtin_amdgcn_rcpf(fl(bf_hi(b.z))); v1[2] *= bf_lo(a.w) * __builtin_amdgcn_rcpf(fl(bf_lo(b.w))); v1[3] *= bf_hi(a.w) * __builtin_amdgcn_rcpf(fl(bf_hi(b.w)));
                    asm volatile("" : "+v"(v0), "+v"(v1) :: "memory"); } }
    }
    __device__ __forceinline__ void operator()(const f32x4 (&acc)[2][2][4][2], const Unit& u, int wr, int wc, int fr, int fq) const {
        unsigned row0 = (unsigned)(u.pm * BM + wr * 64 + fr); asm volatile("" : "+v"(row0));     const int col0 = u.pn * BM + wc * 32 + 8 * fq;
#pragma unroll
        for (int ai = 0; ai < 2; ++ai)
#pragma unroll
            for (int m = 0; m < 4; ++m) { const unsigned off = (row0 + (unsigned)(ai * HALF + m * 16)) * 1024u + (unsigned)col0;
#pragma unroll
                for (int bj = 0; bj < 2; ++bj) { const u32x4 g = *(const u32x4*)(sgb + off + bj * HALF); f32x4 v0 = acc[ai][bj][m][0], v1 = acc[ai][bj][m][1];
                    v0[0] *= fl(bf_lo(g.x)); v0[1] *= fl(bf_hi(g.x)); v0[2] *= fl(bf_lo(g.y)); v0[3] *= fl(bf_hi(g.y)); v1[0] *= fl(bf_lo(g.z)); v1[1] *= fl(bf_hi(g.z)); v1[2] *= fl(bf_lo(g.w)); v1[3] *= fl(bf_hi(g.w));
                    *(u32x4*)(out + off + bj * HALF) = pack8(v0, v1); } }
    }
};
struct EpiResF32 {
    static constexpr bool PERM = false, AFTER_DRAIN = false, HAS_MID = false;
    const float* x; float* out;
    __device__ __forceinline__ void operator()(const f32x4 (&acc)[2][2][4][2], const Unit& u, int wr, int wc, int fr, int fq) const {
        unsigned row0 = (unsigned)(u.pm * BM + wr * 64 + fr); asm volatile("" : "+v"(row0));     const int col0 = u.pn * BM + wc * 32 + 4 * fq;
#pragma unroll
        for (int ai = 0; ai < 2; ++ai)
#pragma unroll
            for (int m = 0; m < 4; ++m) { const unsigned off = (row0 + (unsigned)(ai * HALF + m * 16)) * 1024u + (unsigned)col0;
#pragma unroll
                for (int bj = 0; bj < 2; ++bj)
#pragma unroll
                    for (int n = 0; n < 2; ++n) { const f32x4 xv = *(const f32x4*)(x + off + bj * HALF + n * 16); *(f32x4*)(out + off + bj * HALF + n * 16) = xv * ALPHA + acc[ai][bj][m][n]; } }
    }
};
struct EpiSwiglu {
    static constexpr bool PERM = true, AFTER_DRAIN = false, HAS_MID = false;
    bf16_t* out;
    __device__ __forceinline__ void operator()(const f32x4 (&acc)[2][2][4][2], const Unit& u, int wr, int wc, int fr, int fq) const {
        unsigned row0 = (unsigned)(u.pm * BM + wr * 64 + fr); asm volatile("" : "+v"(row0));     const int col0 = u.pn * HALF + wc * 32 + 8 * fq;
#pragma unroll
        for (int ai = 0; ai < 2; ++ai)
#pragma unroll
            for (int m = 0; m < 4; ++m) { f32x4 v[2];
#pragma unroll
                for (int n = 0; n < 2; ++n)
#pragma unroll
                    for (int e = 0; e < 4; ++e) { const float g = acc[ai][0][m][n][e]; v[n][e] = g * sigmoidf_(g) * acc[ai][1][m][n][e]; }
                *(u32x4*)(out + (row0 + ai * HALF + m * 16) * DFF + col0) = pack8(v[0], v[1]); }
    }
};
struct EpiResBf {
    static constexpr bool PERM = false, AFTER_DRAIN = false, HAS_MID = false;
    const bf16_t* h; float* out;
    __device__ __forceinline__ void operator()(const f32x4 (&acc)[2][2][4][2], const Unit& u, int wr, int wc, int fr, int fq) const {
        unsigned row0 = (unsigned)(u.pm * BM + wr * 64 + fr); asm volatile("" : "+v"(row0));     const int col0 = u.pn * BM + wc * 32 + 4 * fq;
#pragma unroll
        for (int ai = 0; ai < 2; ++ai)
#pragma unroll
            for (int m = 0; m < 4; ++m) { const unsigned off = (row0 + (unsigned)(ai * HALF + m * 16)) * 1024u + (unsigned)col0;
#pragma unroll
                for (int bj = 0; bj < 2; ++bj)
#pragma unroll
                    for (int n = 0; n < 2; ++n) { const u32x2 hv = *(const u32x2*)(h + off + bj * HALF + n * 16); const f32x4 a = acc[ai][bj][m][n];
                        *(f32x4*)(out + off + bj * HALF + n * 16) = (f32x4){bf_lo(hv.x) * ALPHA + a[0], bf_hi(hv.x) * ALPHA + a[1], bf_lo(hv.y) * ALPHA + a[2], bf_hi(hv.y) * ALPHA + a[3]}; } }
    }
};

template <class Epi, class Sched, bool ALIGN_EPI = false>
__device__ __forceinline__ void gemm_phase(PG8_LAS unsigned char* lds, const Gemm g, const Sched& S, const Epi& E) {
    int tid_ = threadIdx.x; asm volatile("" : "+v"(tid_));
    const int tid = tid_, wid = __builtin_amdgcn_readfirstlane(tid >> 6), lane = tid & 63, wr = wid >> 2, wc = wid & 3, fr = lane & 15, fq = lane >> 4;
    int K_ = g.K, lda_ = g.lda, ldb_ = g.ldb; asm volatile("" : "+s"(K_)); asm volatile("" : "+s"(lda_)); asm volatile("" : "+s"(ldb_));
    const int K = K_, nt = K / BK;
    unsigned voffA[2], voffB[2];
#pragma unroll
    for (int i = 0; i < 2; ++i) { int R, C; stage_rc(tid * 16 + i * 8192, R, C); const int Rb = Epi::PERM ? ((R & ~31) + perm32(R & 31)) : R;
        voffA[i] = (unsigned)(R * lda_ + C) * 2u; voffB[i] = (unsigned)(Rb * ldb_ + C) * 2u; }
    const size_t kstep = (size_t)(BK * 2);
    const size_t hstepA = (size_t)HALF * lda_ * 2, hstepB = (size_t)HALF * ldb_ * 2;
    const size_t tstepA = 2 * hstepA, tstepB = 2 * hstepB;
    const unsigned ldsw = (unsigned)wid * 1024u;
    const int aoff = lds_byte(wr * 64 + fr, fq * 8), boff = lds_byte(wc * 32 + fr, fq * 8);
#define PG8_SA(b, h) (((b) * 2 + (h)) * HTB)
#define PG8_SB(b, h) ((4 + (b) * 2 + (h)) * HTB)
#define PG8_STAGE(bufoff, gbase, voff) do { _Pragma("unroll") for (int _i = 0; _i < 2; ++_i) \
        __builtin_amdgcn_global_load_lds((const unsigned*)((const char*)(gbase) + (voff)[_i]), (PG8_LAS unsigned*)(lds + (bufoff) + ldsw + _i * 8192), 16, 0, 0); } while (0)
#define PG8_LDA(dst, b, h) do { _Pragma("unroll") for (int m = 0; m < 4; ++m) _Pragma("unroll") for (int k = 0; k < 2; ++k) dst[m][k] = *(const PG8_LAS bf16x8*)(lds + PG8_SA(b, h) + aoff + m * 2048 + k * 1024); } while (0)
#define PG8_LDB(dst, b, h) do { _Pragma("unroll") for (int n = 0; n < 2; ++n) _Pragma("unroll") for (int k = 0; k < 2; ++k) dst[n][k] = *(const PG8_LAS bf16x8*)(lds + PG8_SB(b, h) + boff + n * 2048 + k * 1024); } while (0)
#define PG8_MMA(ai, bj, At, Bt) do { __builtin_amdgcn_s_setprio(1); _Pragma("unroll") for (int m = 0; m < 4; ++m) _Pragma("unroll") for (int n = 0; n < 2; ++n) _Pragma("unroll") for (int k = 0; k < 2; ++k) \
        acc[ai][bj][m][n] = __builtin_amdgcn_mfma_f32_16x16x32_bf16(Bt[n][k], At[m][k], acc[ai][bj][m][n], 0, 0, 0); __builtin_amdgcn_s_setprio(0); } while (0)
#define PG8_WAIT_V(n) asm volatile("s_waitcnt vmcnt(" #n ")" ::: "memory")
#define PG8_WAIT_L(n) asm volatile("s_waitcnt lgkmcnt(" #n ")" ::: "memory")
#define PG8_BAR __builtin_amdgcn_s_barrier()
#define PG8_SCHED __builtin_amdgcn_sched_barrier(0)
    Unit cur, nxt; int ui = 0;
    if (!S.next(0, cur)) return;
    f32x4 acc[2][2][4][2];
#pragma unroll
    for (int a = 0; a < 2; ++a)
#pragma unroll
        for (int b = 0; b < 2; ++b)
#pragma unroll
            for (int m = 0; m < 4; ++m)
#pragma unroll
                for (int n = 0; n < 2; ++n) acc[a][b][m][n] = (f32x4){0.f, 0.f, 0.f, 0.f};
    bf16x8 At[4][2], B0[2][2], B1[2][2];
    const char* cA = (const char*)g.A + (size_t)cur.pm * tstepA; const char* cB = (const char*)g.Bt + (size_t)cur.pn * tstepB;
    S.a_ready(cur);
    {
        PG8_STAGE(PG8_SB(0, 0), cB, voffB); PG8_STAGE(PG8_SB(0, 1), cB + hstepB, voffB); PG8_STAGE(PG8_SA(0, 0), cA, voffA); PG8_STAGE(PG8_SA(0, 1), cA + hstepA, voffA);
        if (wr == 1) PG8_BAR;
        PG8_WAIT_V(2); PG8_BAR;
        PG8_STAGE(PG8_SB(1, 0), cB + kstep, voffB); PG8_STAGE(PG8_SA(1, 0), cA + kstep, voffA); PG8_STAGE(PG8_SB(1, 1), cB + hstepB + kstep, voffB);
        PG8_WAIT_V(6); PG8_BAR;
    }
    for (;;) {
        const bool has_next = S.next(ui + 1, nxt);
        const char* nA = has_next ? (const char*)g.A + (size_t)nxt.pm * tstepA : cA; const char* nB = has_next ? (const char*)g.Bt + (size_t)nxt.pn * tstepB : cB;
        for (int t = 0; t < nt; t += 2) {
            const bool last = (t == nt - 2);
            const char* a1 = cA + (size_t)(t + 1) * kstep;
            const char* a2 = last ? nA : cA + (size_t)(t + 2) * kstep; const char* b2 = last ? nB : cB + (size_t)(t + 2) * kstep;
            const char* a3 = a2 + kstep; const char* b3 = b2 + kstep;
            if (last && has_next) S.a_ready(nxt);
            if constexpr (Epi::HAS_MID) { if (t == (nt >> 1)) E.mid(acc, cur, wr, wc, fr, fq); }
            {
            PG8_LDB(B0, 0, 0); PG8_LDB(B1, 0, 1); PG8_SCHED; PG8_LDA(At, 0, 0); PG8_STAGE(PG8_SA(1, 1), a1 + hstepA, voffA);
            PG8_WAIT_V(8); PG8_WAIT_L(0); PG8_BAR; PG8_MMA(0, 0, At, B0); PG8_MMA(0, 1, At, B1); PG8_BAR; PG8_SCHED;
            PG8_LDA(At, 0, 1); PG8_STAGE(PG8_SB(0, 0), b2, voffB); PG8_STAGE(PG8_SB(0, 1), b2 + hstepB, voffB); PG8_STAGE(PG8_SA(0, 0), a2, voffA);
            PG8_WAIT_V(8); PG8_WAIT_L(0); PG8_BAR; PG8_MMA(1, 0, At, B0); PG8_MMA(1, 1, At, B1); PG8_BAR; PG8_SCHED;
            PG8_LDB(B0, 1, 0); PG8_LDB(B1, 1, 1); PG8_SCHED; PG8_LDA(At, 1, 0); PG8_STAGE(PG8_SA(0, 1), a2 + hstepA, voffA);
            PG8_WAIT_V(8); PG8_WAIT_L(0); PG8_BAR; PG8_MMA(0, 0, At, B0); PG8_MMA(0, 1, At, B1); PG8_BAR; PG8_SCHED;
            PG8_LDA(At, 1, 1); PG8_STAGE(PG8_SB(1, 0), b3, voffB); PG8_STAGE(PG8_SB(1, 1), b3 + hstepB, voffB); PG8_STAGE(PG8_SA(1, 0), a3, voffA);
            PG8_WAIT_V(8); PG8_WAIT_L(0); PG8_BAR; PG8_MMA(1, 0, At, B0); PG8_MMA(1, 1, At, B1); PG8_BAR; PG8_SCHED;
            }
        }
        if constexpr (ALIGN_EPI) { if (wr == 0) PG8_BAR; }
        if constexpr (!Epi::AFTER_DRAIN) { E(acc, cur, wr, wc, fr, fq); S.done(cur); }
        if (!has_next) break;
#pragma unroll
        for (int a = 0; a < 2; ++a)
#pragma unroll
            for (int b = 0; b < 2; ++b)
#pragma unroll
                for (int m = 0; m < 4; ++m)
#pragma unroll
                    for (int n = 0; n < 2; ++n) acc[a][b][m][n] = (f32x4){0.f, 0.f, 0.f, 0.f};
        cur = nxt; cA = nA; cB = nB; ++ui;
        if constexpr (ALIGN_EPI) { if (wr == 1) PG8_BAR; }
    }
    PG8_WAIT_V(0);
    if constexpr (!ALIGN_EPI) { if (wr == 0) PG8_BAR; }
    PG8_BAR;
    if constexpr (Epi::AFTER_DRAIN) { E.fused(acc, cur, wr, wc, fr, fq, lds, wid, lane); S.done(cur); }
#undef PG8_SA
#undef PG8_SB
#undef PG8_STAGE
#undef PG8_LDA
#undef PG8_LDB
#undef PG8_MMA
#undef PG8_WAIT_V
#undef PG8_WAIT_L
#undef PG8_BAR
#undef PG8_SCHED
}
}

namespace att {
using bf16 = unsigned short;
using bf16x8 = __attribute__((ext_vector_type(8))) short;
using s16x4 = __attribute__((ext_vector_type(4))) short;
using f32x16 = __attribute__((ext_vector_type(16))) float;
using u32x4 = __attribute__((ext_vector_type(4))) unsigned;
using u32x2 = __attribute__((ext_vector_type(2))) unsigned;
constexpr int NW = 8, QBLK = 32, QB = 256, KVBLK = 64, NSLOT = 3;
constexpr int KSLOT = 12288, VSLOT = 8192;
constexpr int LDS_K = 0, LDS_V = NSLOT * KSLOT, LDS_WS = LDS_V + NSLOT * VSLOT, LDS_OST = LDS_WS + NW * 64 * 4, LDS_BYTES = LDS_OST + NW * 4096;
__device__ __forceinline__ int crow(int r, int hi) { return (r & 3) + 8 * (r >> 2) + 4 * hi; }
#define ATT_SBAR() __builtin_amdgcn_sched_barrier(0)
__device__ __forceinline__ void glds16(const void* gsrc, unsigned lds_dst) { unsigned keep;
    asm volatile("s_mov_b32 %0, m0\n\ts_mov_b32 m0, %2\n\ts_nop 0\n\tglobal_load_lds_dwordx4 %1, off\n\ts_mov_b32 m0, %0" : "=&s"(keep) : "v"(gsrc), "s"(lds_dst) : "memory"); }
__device__ __forceinline__ float max3f(float a, float b, float c) { float r; asm("v_max3_f32 %0, %1, %2, %3" : "=v"(r) : "v"(a), "v"(b), "v"(c)); return r; }
typedef float f32x2_t __attribute__((ext_vector_type(2))); typedef __bf16 bf16x2_t __attribute__((ext_vector_type(2)));
__device__ __forceinline__ unsigned cvtpk_s(float lo, float hi) { f32x2_t v = {lo, hi}; bf16x2_t b = __builtin_convertvector(v, bf16x2_t); return __builtin_bit_cast(unsigned, b); }
#define ATT_WAIT_BAR(N) asm volatile("s_waitcnt vmcnt(" #N ") lgkmcnt(0)\n\ts_barrier" ::: "memory")
typedef __attribute__((address_space(3))) char LDSC;
#define ATT_LAS __attribute__((address_space(3)))

__device__ __forceinline__ float rowmax(const f32x16& p0, const f32x16& p1) {
    float a = max3f(p0[0], p0[1], p1[0]), b = max3f(p0[2], p0[3], p1[1]); a = max3f(a, p1[2], p1[3]);
#pragma unroll
    for (int r = 4; r < 16; r += 4) { a = max3f(a, p0[r], p0[r + 1]); b = max3f(b, p0[r + 2], p0[r + 3]); a = max3f(a, p1[r], p1[r + 1]); b = max3f(b, p1[r + 2], p1[r + 3]); }
    const float m = fmaxf(a, b);
    auto rr = __builtin_amdgcn_permlane32_swap(__float_as_uint(m), __float_as_uint(m), false, false);
    return fmaxf(__uint_as_float(rr[0]), __uint_as_float(rr[1]));
}
__device__ __forceinline__ void pv(f32x16* o, int vb, bf16x8 pa0, bf16x8 pa1, bf16x8 pa2, bf16x8 pa3) {
#pragma unroll
    for (int d0 = 0; d0 < 2; ++d0) { s16x4 lo[4], hi[4];
#pragma unroll
        for (int ks = 0; ks < 4; ++ks) {
            asm volatile("ds_read_b64_tr_b16 %0,%1 offset:%c2" : "=&v"(lo[ks]) : "v"(vb), "i"(d0 * 4096 + ks * 1024) : "memory");
            asm volatile("ds_read_b64_tr_b16 %0,%1 offset:%c2" : "=&v"(hi[ks]) : "v"(vb), "i"(d0 * 4096 + ks * 1024 + 512) : "memory"); }
        asm volatile("s_waitcnt lgkmcnt(0)" : "+v"(lo[0]), "+v"(lo[1]), "+v"(lo[2]), "+v"(lo[3]), "+v"(hi[0]), "+v"(hi[1]), "+v"(hi[2]), "+v"(hi[3]) :: "memory"); ATT_SBAR();
#define ATT_PK(k) (bf16x8){lo[k][0], lo[k][1], lo[k][2], lo[k][3], hi[k][0], hi[k][1], hi[k][2], hi[k][3]}
        o[d0] = __builtin_amdgcn_mfma_f32_32x32x16_bf16(pa0, ATT_PK(0), o[d0], 0, 0, 0);
        o[d0] = __builtin_amdgcn_mfma_f32_32x32x16_bf16(pa1, ATT_PK(1), o[d0], 0, 0, 0);
        o[d0] = __builtin_amdgcn_mfma_f32_32x32x16_bf16(pa2, ATT_PK(2), o[d0], 0, 0, 0);
        o[d0] = __builtin_amdgcn_mfma_f32_32x32x16_bf16(pa3, ATT_PK(3), o[d0], 0, 0, 0);
#undef ATT_PK
    }
}

struct AttnArgs {
    const bf16* Q; int qpitch;
    const bf16* K; int kpitch;
    const bf16* V; int vpitch;
    bf16* O; int opitch; int ocol;
    const unsigned* mask;
};

template <int NDK, bool DSA> __device__ __forceinline__ void attn_unit(int b, int h, int qb, const AttnArgs& T, float slope2, LDSC* shm) {
    constexpr int DQK = NDK * 16, NKP = 2 * NDK;
    int tid_ = threadIdx.x; asm volatile("" : "+v"(tid_));
    const int tid = tid_, lane = tid & 63, r32 = lane & 31, hi = lane >> 5; const int wid = __builtin_amdgcn_readfirstlane(tid >> 6);
    const long rowbase = (long)b * SEQ; const int q0 = qb * QB;
    const bf16* Qw = T.Q + (rowbase + q0 + wid * QBLK) * T.qpitch + h * DQK;
    const bf16* Kh = T.K + rowbase * T.kpitch + h * DQK; const bf16* Vh = T.V + rowbase * T.vpitch + h * 64;
    const unsigned lds0 = (unsigned)(uintptr_t)shm;
    ATT_LAS float* wsf = (ATT_LAS float*)(shm + LDS_WS) + wid * 64;
    const bf16* ksrc0 = Kh + (long)lane * T.kpitch + wid * 8;
    const bf16* ksrc1 = Kh + (long)lane * T.kpitch + (8 + wid) * 8;
    const bf16* vsrc = Vh + (long)(16 * (wid & 3) + (lane >> 2)) * T.vpitch + (wid >> 2) * 32 + (lane & 3) * 8;
    const bool k2 = (NKP > 8) && (wid < NKP - 8);
    const long kstep = (long)KVBLK * T.kpitch, vstep = (long)KVBLK * T.vpitch;
    const int NT = (q0 + QB) / KVBLK;
    const long qrow = rowbase + q0 + wid * QBLK + r32;
    const unsigned* mrow = DSA ? (T.mask + qrow * 64) : nullptr;
#define ATT_DMA(t, slot) do { const int s_ = (slot); glds16(ksrc0 + (long)(t) * kstep, (unsigned)__builtin_amdgcn_readfirstlane(lds0 + LDS_K + s_ * KSLOT + wid * 1024)); \
        if (k2) glds16(ksrc1 + (long)(t) * kstep, (unsigned)__builtin_amdgcn_readfirstlane(lds0 + LDS_K + s_ * KSLOT + (8 + wid) * 1024)); \
        glds16(vsrc + (long)(t) * vstep, (unsigned)__builtin_amdgcn_readfirstlane(lds0 + LDS_V + s_ * VSLOT + wid * 1024)); } while (0)
#define ATT_TOPWAIT(younger) do { if (younger) { if (k2) ATT_WAIT_BAR(3); else ATT_WAIT_BAR(2); } else ATT_WAIT_BAR(0); } while (0)
    u32x2 mnext = {0u, 0u};
    if (DSA) mnext = *(const u32x2*)mrow;
    ATT_DMA(0, 0); ATT_DMA(1, 1);
    bf16x8 qr[NDK];
#pragma unroll
    for (int d0 = 0; d0 < NDK; ++d0) qr[d0] = *reinterpret_cast<const bf16x8*>(&Qw[(long)r32 * T.qpitch + d0 * 16 + hi * 8]);
    float m_run = -INFINITY, l_run = 0.f; f32x16 o[2]; o[0] = f32x16{}; o[1] = f32x16{};
    const int qrel = wid * QBLK + r32;
    f32x16 cb0 = f32x16{}, cb1 = f32x16{};
    if (DSA) {
#pragma unroll
        for (int r = 0; r < 16; ++r) { cb0[r] = -slope2 * (float)(q0 + qrel - crow(r, hi)); cb1[r] = cb0[r] + 32.f * slope2; }
    }
    const int vb0 = (int)(lds0 + LDS_V) + ((lane >> 4) & 1) * 32 + (lane & 3) * 8 + (4 * hi + ((lane & 15) >> 2)) * 64;
    int slot = 0;
    for (int t = 0; t < NT; ++t) {
        ATT_TOPWAIT(t + 1 < NT);
        u32x2 mcur = {0u, 0u};
        if (DSA) { mcur = mnext; asm volatile("" : "+v"(mcur)); }
        if (t + 2 < NT) { const int s2 = (slot == 0) ? 2 : slot - 1; ATT_DMA(t + 2, s2); }
        if (DSA) { if (t + 1 < NT) mnext = *(const u32x2*)(mrow + 2 * (t + 1)); }
        const int jb = t - (NT - 4);
        const bool active = (jb < 0) || (64 * jb <= wid * QBLK + 31);
        if (active) {
            f32x16 p0 = cb0, p1 = cb1;
            const LDSC* kb = shm + LDS_K + slot * KSLOT + hi * 1024 + r32 * 16;
#pragma unroll
            for (int d0 = 0; d0 < NDK; ++d0) {
                const bf16x8 b0 = *(const ATT_LAS bf16x8*)(kb + d0 * 2048);
                const bf16x8 b1 = *(const ATT_LAS bf16x8*)(kb + d0 * 2048 + 512);
                p0 = __builtin_amdgcn_mfma_f32_32x32x16_bf16(b0, qr[d0], p0, 0, 0, 0);
                p1 = __builtin_amdgcn_mfma_f32_32x32x16_bf16(b1, qr[d0], p1, 0, 0, 0); }
            asm volatile("s_nop 15\n\ts_nop 7" : "+v"(p0), "+v"(p1));
            if (DSA) {
                const unsigned w0 = mcur.x >> (4 * hi), w1 = mcur.y >> (4 * hi);
#pragma unroll
                for (int r = 0; r < 16; ++r) { const int bit = (r & 3) + 8 * (r >> 2);
                    if (!((w0 >> bit) & 1u)) p0[r] = -INFINITY; if (!((w1 >> bit) & 1u)) p1[r] = -INFINITY; }
            } else if (jb >= 0) {
                const int kb0 = 64 * jb + 4 * hi;
#pragma unroll
                for (int r = 0; r < 16; ++r) { const int kv = kb0 + (r & 3) + 8 * (r >> 2); if (kv > qrel) p0[r] = -INFINITY; if (kv + 32 > qrel) p1[r] = -INFINITY; }
            }
            const float rm = rowmax(p0, p1);
            const float mn = fmaxf(m_run, rm);
            const float mu = (mn == -INFINITY) ? 0.f : mn;
            const float f = __builtin_amdgcn_exp2f(m_run - mu);
            float rs = 0.f;
#pragma unroll
            for (int r = 0; r < 16; ++r) { p0[r] = __builtin_amdgcn_exp2f(p0[r] - mu); p1[r] = __builtin_amdgcn_exp2f(p1[r] - mu); rs += p0[r] + p1[r]; }
            l_run = l_run * f + rs;
            if (__any(mn > m_run)) {
                if (hi == 0) wsf[r32] = f;
                asm volatile("s_waitcnt lgkmcnt(0)" ::: "memory");
#pragma unroll
                for (int r = 0; r < 16; ++r) { const float fr_ = wsf[crow(r, hi)]; o[0][r] *= fr_; o[1][r] *= fr_; }
            }
            m_run = mn;
            u32x4 pw0, pw1, pw2, pw3;
            pw0 = (u32x4){cvtpk_s(p0[0], p0[1]), cvtpk_s(p0[2], p0[3]), cvtpk_s(p0[4], p0[5]), cvtpk_s(p0[6], p0[7])};
            pw1 = (u32x4){cvtpk_s(p0[8], p0[9]), cvtpk_s(p0[10], p0[11]), cvtpk_s(p0[12], p0[13]), cvtpk_s(p0[14], p0[15])};
            pw2 = (u32x4){cvtpk_s(p1[0], p1[1]), cvtpk_s(p1[2], p1[3]), cvtpk_s(p1[4], p1[5]), cvtpk_s(p1[6], p1[7])};
            pw3 = (u32x4){cvtpk_s(p1[8], p1[9]), cvtpk_s(p1[10], p1[11]), cvtpk_s(p1[12], p1[13]), cvtpk_s(p1[14], p1[15])};
            ATT_SBAR();
            pv(o, vb0 + slot * VSLOT, __builtin_bit_cast(bf16x8, pw0), __builtin_bit_cast(bf16x8, pw1), __builtin_bit_cast(bf16x8, pw2), __builtin_bit_cast(bf16x8, pw3));
        }
        if (DSA) {
#pragma unroll
            for (int r = 0; r < 16; ++r) { cb0[r] += 64.f * slope2; cb1[r] += 64.f * slope2; }
        }
        slot = (slot == NSLOT - 1) ? 0 : slot + 1;
    }
    { auto rr = __builtin_amdgcn_permlane32_swap(__float_as_uint(l_run), __float_as_uint(l_run), false, false); l_run = __uint_as_float(rr[0]) + __uint_as_float(rr[1]); }
    if (hi == 0) wsf[32 + r32] = l_run;
    asm volatile("s_waitcnt lgkmcnt(0)" ::: "memory");
    float rli[16];
#pragma unroll
    for (int r = 0; r < 16; ++r) rli[r] = __builtin_amdgcn_rcpf(wsf[32 + crow(r, hi)]);
    bf16* Ow = T.O + (rowbase + q0 + wid * QBLK) * T.opitch + T.ocol + h * 64;
    { ATT_LAS bf16* stg = (ATT_LAS bf16*)(shm + LDS_OST) + wid * 2048;
#pragma unroll
        for (int r = 0; r < 16; ++r) { const int orow = crow(r, hi);
#pragma unroll
            for (int d0 = 0; d0 < 2; ++d0) stg[orow * 64 + d0 * 32 + r32] = (bf16)(cvtpk_s(o[d0][r] * rli[r], 0.f) & 0xffffu); }
        asm volatile("s_waitcnt lgkmcnt(0)" ::: "memory");
#pragma unroll
        for (int i = 0; i < 4; ++i) { const int row = i * 8 + (lane >> 3), ch = lane & 7; const u32x4 v = *(const ATT_LAS u32x4*)(stg + row * 64 + ch * 8); *(u32x4*)(Ow + (long)row * T.opitch + ch * 8) = v; } }
    asm volatile("s_waitcnt vmcnt(0) lgkmcnt(0)\n\ts_barrier" ::: "memory");
#undef ATT_DMA
#undef ATT_TOPWAIT
}
#undef ATT_LAS
#undef ATT_SBAR
#undef ATT_WAIT_BAR
}


constexpr int NWAVES = 8;
#ifndef MK_N_LAUNCHES
#define MK_N_LAUNCHES 1
#endif
constexpr int PER_PHASE = 12;
constexpr int N_LAUNCHES = MK_N_LAUNCHES;
static_assert(N_LAUNCHES == 1 || N_LAUNCHES == PER_PHASE, "MK_N_LAUNCHES is 1 or 12");

constexpr size_t MiB = 1u << 20;
constexpr size_t WS_CTL = 0, CTL_ZERO_BYTES = 64 * 1024;
constexpr size_t WS_W_IN = 1 * MiB, WS_W_UQ = 10 * MiB, WS_W_UKV = 10 * MiB + 512 * 1024, WS_W_A = 11 * MiB, WS_W_B = 12 * MiB, WS_W_OUT = 13 * MiB, WS_W_FFI = 15 * MiB, WS_W_DN = 26 * MiB;
constexpr size_t WS_COS = 32 * MiB, WS_SIN = 36 * MiB, WS_SSQ_Q = 40 * MiB, WS_SSQ_KV = 41 * MiB, WS_WI = 42 * MiB, WS_KI = 44 * MiB;
constexpr size_t WS_XB = 64 * MiB;
constexpr size_t WS_VA = 64 * MiB;
constexpr size_t WS_O = 128 * MiB;
constexpr size_t WS_MIXED = 256 * MiB;
constexpr size_t WS_H1 = 64 * MiB;
constexpr size_t WS_CQ = 192 * MiB, WS_CKV = 224 * MiB;
constexpr size_t WS_MASK = 48 * MiB;
constexpr size_t WS_QB = 256 * MiB, WS_KB = 320 * MiB, WS_VB = 384 * MiB;
constexpr size_t WS_QI = 448 * MiB;
constexpr size_t WS_SGA = 480 * MiB, WS_SGB = 608 * MiB;
constexpr size_t WS_KMLA = 736 * MiB;
constexpr size_t WS_QMLA = 832 * MiB;
constexpr size_t WS_ACT = 480 * MiB;
constexpr size_t WS_END = 928 * MiB;
static_assert(WS_ACT + (size_t)M * DFF * 2 <= WS_END && WS_W_DN + (size_t)DM * DFF * 2 <= WS_COS && WS_W_IN + (size_t)N_IN * DM * 2 <= WS_W_UQ && WS_W_FFI + (size_t)2 * DFF * DM * 2 <= WS_W_DN, "d_ws map");
constexpr int CW_TMO = 0;
constexpr int CW_BAR = 4096;

constexpr int RING_OFF = 0, RING_BYTES = 147456;
constexpr int LDSCTL_OFF = RING_BYTES, MISC_OFF = LDSCTL_OFF + 320;
constexpr int LDS_BYTES = RING_BYTES + 1024;
static_assert(att::LDS_BYTES <= RING_BYTES && pg8::STAGE_BYTES <= RING_BYTES && LDS_BYTES <= 163840, "LDS map");

typedef unsigned u32x2v __attribute__((ext_vector_type(2)));
#define GAS __attribute__((address_space(1)))
#define LAS __attribute__((address_space(3)))
typedef unsigned short bf16;
typedef unsigned v4u __attribute__((ext_vector_type(4)));
typedef float f32x4 __attribute__((ext_vector_type(4)));
typedef short bf16x8 __attribute__((ext_vector_type(8)));
typedef GAS unsigned gu32;
typedef GAS unsigned long long gu64;
#define RLX_AGENT __ATOMIC_RELAXED, __HIP_MEMORY_SCOPE_AGENT
#define LDS_WAIT() asm volatile("s_waitcnt lgkmcnt(0)" ::: "memory")
#define VM_WAIT() asm volatile("s_waitcnt vmcnt(0)" ::: "memory")
__device__ __forceinline__ unsigned long long rt() { return __builtin_amdgcn_s_memrealtime(); }
__device__ __forceinline__ unsigned f2bf(float f) { unsigned u = __builtin_bit_cast(unsigned, f); return (u + 0x7fffu + ((u >> 16) & 1u)) >> 16; }
__device__ __forceinline__ unsigned pk2(float lo, float hi) { return f2bf(lo) | (f2bf(hi) << 16); }

#define XB_TMO      128
#define XB_XCNT(j)  (256  + 64 * (j))
#define XB_XSUB(j)  (1280 + 64 * (j))
#define XB_XGEN(j)  (2304 + 64 * (j))
#define XB_TOP      3328
#define XB_TOPGEN   3392
#define XCD_BAR_WORDS 3456
#define XB_SPIN_CAP (1u << 18)

__device__ __forceinline__ unsigned xb_ld(unsigned* p)              { return __hip_atomic_load(p, __ATOMIC_RELAXED, __HIP_MEMORY_SCOPE_AGENT); }
__device__ __forceinline__ unsigned xb_add(unsigned* p, unsigned v) { return __hip_atomic_fetch_add(p, v, __ATOMIC_RELAXED, __HIP_MEMORY_SCOPE_AGENT); }
__device__ __forceinline__ unsigned xb_xcc_id() { return (unsigned)__builtin_amdgcn_s_getreg((3 << 11) | 20) & 0xFu; }
#define XB_SPIN(cond, bar) do { unsigned _sp = 0; while (cond) { __builtin_amdgcn_s_sleep(1); \
    if ((++_sp & 255u) == 0u) { if (xb_ld(&(bar)[XB_TMO])) break; if (_sp > XB_SPIN_CAP) { atomicAdd(&(bar)[XB_TMO], 1u); break; } } } } while (0)

struct XcdBarrier {
    unsigned* bar; unsigned x;
    volatile LAS unsigned* st;
};

__device__ __forceinline__ XcdBarrier xcd_barrier_post(unsigned* bar, volatile LAS unsigned* st) {
    XcdBarrier b; b.bar = bar; b.x = xb_xcc_id(); b.st = st;
    if (threadIdx.x == 0) (void)xb_add(&bar[XB_XCNT(b.x)], 1u);
    return b;
}
__device__ __forceinline__ void xcd_barrier_complete(unsigned* bar, unsigned x, unsigned& nloc, unsigned& nx) {
    const unsigned G = gridDim.x * gridDim.y * gridDim.z;
    unsigned sum, cnt, mine, sp = 0u;
    for (;;) {
        sum = 0u; cnt = 0u; mine = 0u;
#pragma unroll
        for (unsigned j = 0; j < 16; ++j) { const unsigned c = xb_ld(&bar[XB_XCNT(j)]); sum += c; cnt += (c > 0u) ? 1u : 0u; mine = (j == x) ? c : mine; }
        if (sum == G) break;
        __builtin_amdgcn_s_sleep(1);
        if ((++sp & 255u) == 0u) { if (xb_ld(&bar[XB_TMO])) break; if (sp > XB_SPIN_CAP) { atomicAdd(&bar[XB_TMO], 1u); break; } }
    }
    nloc = mine > 0u ? mine : 1u; nx = cnt > 0u ? cnt : 1u;
}

__device__ __forceinline__ void xcd_barrier(const XcdBarrier& b) {
    asm volatile("s_waitcnt vmcnt(0)" ::: "memory");
    __syncthreads();
    if (threadIdx.x == 0) {
        unsigned* bar = b.bar;
        __builtin_amdgcn_s_waitcnt(0);
        unsigned nloc = b.st[0], nx = b.st[1];
        if (nloc == 0u) { xcd_barrier_complete(bar, b.x, nloc, nx); b.st[0] = nloc; b.st[1] = nx; }
        const unsigned old = xb_add(&bar[XB_XSUB(b.x)], 1u);
        const unsigned gen = old / nloc;
        if (old + 1u == (gen + 1u) * nloc) {
            __builtin_amdgcn_fence(__ATOMIC_RELEASE, "agent");
            asm volatile("s_waitcnt vmcnt(0)" ::: "memory");
            const unsigned og = xb_add(&bar[XB_TOP], 1u);
            const unsigned tg = og / nx;
            if (og + 1u == (tg + 1u) * nx) xb_add(&bar[XB_TOPGEN], 1u);
            else XB_SPIN(xb_ld(&bar[XB_TOPGEN]) == tg, bar);
            __builtin_amdgcn_fence(__ATOMIC_ACQUIRE, "agent");
            xb_add(&bar[XB_XGEN(b.x)], 1u);
            asm volatile("s_waitcnt vmcnt(0)" ::: "memory");
        } else {
            XB_SPIN(xb_ld(&bar[XB_XGEN(b.x)]) == gen, bar);
            __builtin_amdgcn_fence(__ATOMIC_ACQUIRE, "agent");
            asm volatile("s_waitcnt vmcnt(0)" ::: "memory");
        }
    }
    __syncthreads();
}


struct Frame {
    LAS unsigned char* lds;
    volatile LAS unsigned* MISC;
    gu32* ctl;
    int tid, lane, wave;
    int vcu, G;
    unsigned char* ws;
};
#define WSP(T, off) ((T*)(F.ws + (off)))

__device__ __forceinline__ float wave_sum(float v) {
#pragma unroll
    for (int o = 1; o < 64; o <<= 1) v += __shfl_xor(v, o);
    return v;
}
__device__ __forceinline__ void tr_item(const float* W, int ldw, int K, int c0, int nv, bf16* WT, int r0, int k0, const float* gain, LAS float* scr, int lane) {
#pragma unroll 8
    for (int i = 0; i < 32; ++i) { const int kk = 2 * i + (lane >> 5), n = lane & 31; float v = 0.f; if (n < nv) v = W[(size_t)(k0 + kk) * ldw + c0 + n]; if (gain) v *= gain[k0 + kk]; scr[kk * 33 + n] = v; }
    LDS_WAIT(); asm volatile("" ::: "memory");
    const int c = lane & 7;
#pragma unroll
    for (int j = 0; j < 4; ++j) { const int n = (lane >> 3) + 8 * j; const LAS float* s = scr + (8 * c) * 33 + n;
        v4u o; o.x = pk2(s[0 * 33], s[1 * 33]); o.y = pk2(s[2 * 33], s[3 * 33]); o.z = pk2(s[4 * 33], s[5 * 33]); o.w = pk2(s[6 * 33], s[7 * 33]);
        *(GAS v4u*)(WT + (size_t)(r0 + n) * K + k0 + 8 * c) = o; }
    LDS_WAIT(); asm volatile("" ::: "memory");
}
struct InPtrs { const float *x; const int* pos; const float *w_in, *qn, *kvn, *w_uq, *w_ukv, *w_a, *w_b, *w_out, *ln1g, *ln1b, *ffi, *ffd, *ln2g, *ln2b; };

__device__ __forceinline__ void p0_prologue(Frame& F, const InPtrs& I) {
    LAS float* scr = (LAS float*)(F.lds + RING_OFF + F.wave * 16384);
    const int gw = F.vcu * NWAVES + F.wave, NGW = F.G * NWAVES;
    constexpr int I_IN = (N_IN / 32) * (DM / 64), I_UQ = (768 / 32) * (256 / 64), I_UKV = (1024 / 32) * (256 / 64), I_A = (1024 / 32) * (512 / 64), I_B = I_A, I_OUT = (1024 / 32) * (1024 / 64),
                  I_FFI = (2 * DFF / 32) * (DM / 64), I_DN = (DM / 32) * (DFF / 64);
    constexpr int NITEMS = I_IN + I_UQ + I_UKV + I_A + I_B + I_OUT + I_FFI + I_DN;
    for (int it = gw; it < NITEMS; it += NGW) {
        int r = it;
        if (r < I_IN) { const int nb = r / (DM / 64), kb = r % (DM / 64), d = nb * 32; int c0 = 0, nv = 32;
            if (d < 512) c0 = d; else if (d < 1024) c0 = 544 + (d - 512); else if (d < 1536) c0 = 1056 + (d - 1024); else if (d < 2048) c0 = 1568 + (d - 1536); else if (d < 2304) c0 = 2080 + (d - 2048);
            else if (d < 3328) c0 = 2376 + (d - 2304); else if (d < 4352) c0 = 3400 + (d - 3328); else if (d == 4352) c0 = 512; else if (d == 4384) c0 = 2336; else if (d == 4416) { c0 = 2368; nv = 8; } else { c0 = 0; nv = 0; }
            tr_item(I.w_in, D_IN, DM, c0, nv, WSP(bf16, WS_W_IN), d, kb * 64, nullptr, scr, F.lane); continue; } r -= I_IN;
        if (r < I_UQ) { const int nb = r / 4, kb = r % 4; const int c0 = (nb < 16) ? (nb >> 1) * 96 + (nb & 1) * 32 : (nb - 16) * 96 + 64;
            tr_item(I.w_uq, 768, 256, c0, 32, WSP(bf16, WS_W_UQ), nb * 32, kb * 64, I.qn, scr, F.lane); continue; } r -= I_UQ;
        if (r < I_UKV) { const int nb = r / 4, kb = r % 4; const int c0 = (nb < 16) ? (nb >> 1) * 128 + (nb & 1) * 32 : ((nb - 16) >> 1) * 128 + 64 + ((nb - 16) & 1) * 32;
            tr_item(I.w_ukv, 1024, 256, c0, 32, WSP(bf16, WS_W_UKV), nb * 32, kb * 64, I.kvn, scr, F.lane); continue; } r -= I_UKV;
        if (r < I_A) { const int nb = r / 8, kb = r % 8; tr_item(I.w_a, 1024, 1024, nb * 32, 32, WSP(bf16, WS_W_A), nb * 32, kb * 64, nullptr, scr, F.lane); continue; } r -= I_A;
        if (r < I_B) { const int nb = r / 8, kb = r % 8; tr_item(I.w_b, 1024, 1024, nb * 32, 32, WSP(bf16, WS_W_A) + 512, nb * 32, kb * 64, nullptr, scr, F.lane)    ; continue; } r -= I_B;
        if (r < I_OUT) { const int nb = r / 16, kb = r % 16; tr_item(I.w_out, 1024, 1024, nb * 32, 32, WSP(bf16, WS_W_OUT), nb * 32, kb * 64, nullptr, scr, F.lane); continue; } r -= I_OUT;
        if (r < I_FFI) { const int nb = r / 16, kb = r % 16; const int pn = nb >> 3, bj = (nb >> 2) & 1, q = nb & 3;
            tr_item(I.ffi, 2 * DFF, DM, bj * DFF + 128 * pn + 32 * q, 32, WSP(bf16, WS_W_FFI), nb * 32, kb * 64, nullptr, scr, F.lane); continue; } r -= I_FFI;
        { const int nb = r / (DFF / 64), kb = r % (DFF / 64); tr_item(I.ffd, DM, DFF, nb * 32, 32, WSP(bf16, WS_W_DN), nb * 32, kb * 64, nullptr, scr, F.lane); }
    }
    for (int m = gw; m < M; m += NGW) {
        const GAS f32x4* xr = (const GAS f32x4*)(I.x + (size_t)m * DM) + F.lane; GAS unsigned long long* o8 = (GAS unsigned long long*)(WSP(bf16, WS_XB) + (size_t)m * DM) + F.lane;
        f32x4 v[4];
#pragma unroll
        for (int j = 0; j < 4; ++j) v[j] = xr[64 * j];
#pragma unroll
        for (int j = 0; j < 4; ++j) o8[64 * j] = (unsigned long long)pk2(v[j].x, v[j].y) | ((unsigned long long)pk2(v[j].z, v[j].w) << 32);
    }
    for (int m4 = gw; m4 < M / 4; m4 += NGW) {
        const int m = m4 * 4 + (F.lane >> 4), i = F.lane & 15;
        const float invf = exp2f(-(float)i * (13.287712379549449f / 16.0f));
        const float ang = (float)I.pos[m] * invf;
        const double rev = (double)ang * 0.15915494309189535; const float fr = (float)(rev - rint(rev));
        WSP(float, WS_COS)[(size_t)m * 16 + i] = __builtin_amdgcn_cosf(fr); WSP(float, WS_SIN)[(size_t)m * 16 + i] = __builtin_amdgcn_sinf(fr);
    }
}

__device__ __forceinline__ void ln_rows(Frame& F, const float* src, const float* g, const float* bt, bf16* dbf, float* df) {
    const int gw = F.vcu * NWAVES + F.wave, NGW = F.G * NWAVES;
    f32x4 gv[4], bv[4];
#pragma unroll
    for (int j = 0; j < 4; ++j) { gv[j] = ((const GAS f32x4*)g)[F.lane + 64 * j]; bv[j] = ((const GAS f32x4*)bt)[F.lane + 64 * j]; }
    for (int m = gw; m < M; m += NGW) {
        const GAS f32x4* xr = (const GAS f32x4*)(src + (size_t)m * DM) + F.lane;
        f32x4 v[4]; float s = 0.f;
#pragma unroll
        for (int j = 0; j < 4; ++j) { v[j] = xr[64 * j]; s += (v[j].x + v[j].y) + (v[j].z + v[j].w); }
        const float mean = wave_sum(s) * (1.f / DM); float s2 = 0.f;
#pragma unroll
        for (int j = 0; j < 4; ++j) { v[j] = v[j] - mean; s2 += (v[j].x * v[j].x + v[j].y * v[j].y) + (v[j].z * v[j].z + v[j].w * v[j].w); }
        const float rstd = 1.f / sqrtf(wave_sum(s2) * (1.f / DM) + LN_EPS);
#pragma unroll
        for (int j = 0; j < 4; ++j) v[j] = v[j] * rstd * gv[j] + bv[j];
        if (dbf) { GAS unsigned long long* o8 = (GAS unsigned long long*)(dbf + (size_t)m * DM) + F.lane;
#pragma unroll
            for (int j = 0; j < 4; ++j) o8[64 * j] = (unsigned long long)pk2(v[j].x, v[j].y) | ((unsigned long long)pk2(v[j].z, v[j].w) << 32); }
        if (df) { GAS f32x4* o = (GAS f32x4*)(df + (size_t)m * DM) + F.lane;
#pragma unroll
            for (int j = 0; j < 4; ++j) o[64 * j] = v[j]; }
    }
}

__device__ __forceinline__ float relu_(float x) { return __builtin_amdgcn_fmed3f(x, 0.f, __builtin_inff()); }
#define WRLANE(w, sval, ln) asm volatile("s_nop 1\n\tv_writelane_b32 %0, %1, %2" : "+v"(w) : "s"(__builtin_amdgcn_readfirstlane((int)(sval))), "i"(ln))
__device__ __forceinline__ float fmax_s(float a, float b) { float r; asm("v_max_f32_e32 %0, %1, %2" : "=v"(r) : "v"(a), "v"(b)); return r; }
__device__ __forceinline__ float fmin_s(float a, float b) { float r; asm("v_min_f32_e32 %0, %1, %2" : "=v"(r) : "v"(a), "v"(b)); return r; }
__device__ __forceinline__ unsigned fkey(float s) { const unsigned u = __float_as_uint(s); return (u & 0x80000000u) ? ~u : (u | 0x80000000u); }
__device__ __forceinline__ void hist_select(const LAS unsigned* h, int lane, unsigned rm, unsigned& digit, unsigned& above, unsigned& inbin) {
    const u32x2v wv = *(const LAS u32x2v*)(h + lane * 2);
    const unsigned c0 = wv.x & 0xffffu, c1 = wv.x >> 16, c2 = wv.y & 0xffffu, c3 = wv.y >> 16, s = c0 + c1 + c2 + c3;
    unsigned S = s;
#pragma unroll
    for (int off = 1; off < 64; off <<= 1) { const unsigned tt = __shfl_down(S, off); if (lane + off < 64) S += tt; }
    const unsigned above0 = S - s;
    const unsigned long long bal = __ballot((S >= rm) && (above0 < rm));
    const int L = __builtin_amdgcn_readfirstlane((int)__builtin_ctzll(bal | (1ull << 63)));
    unsigned a = above0, dsub, ceq;
    if (a + c3 >= rm) { dsub = 3u; ceq = c3; } else { a += c3; if (a + c2 >= rm) { dsub = 2u; ceq = c2; } else { a += c2; if (a + c1 >= rm) { dsub = 1u; ceq = c1; } else { a += c1; dsub = 0u; ceq = c0; } } }
    digit = (unsigned)__builtin_amdgcn_readlane((int)(4u * (unsigned)lane + dsub), L);
    above = (unsigned)__builtin_amdgcn_readlane((int)a, L); inbin = (unsigned)__builtin_amdgcn_readlane((int)ceq, L);
}
#define IDX_LOOP_BEGIN _Pragma("unroll") for (int g_ = 0; g_ < 16; ++g_) { if (4 * g_ <= qt) { _Pragma("unroll") for (int kb = 4 * g_; kb < 4 * g_ + 4; ++kb) {
#define IDX_LOOP_END } } }
#define IDX_ADD(p, d) __hip_atomic_fetch_add((p) + ((d) >> 1), 1u << (((d) & 1u) * 16u), __ATOMIC_RELAXED, __HIP_MEMORY_SCOPE_WORKGROUP)
__device__ __forceinline__ void idx_task(Frame& F, int b, int qt, const LAS unsigned char* kl, LAS unsigned* hist) {
    int lane_ = F.lane; asm volatile("" : "+v"(lane_));
    const int lane = lane_, hi = lane >> 5, j = lane & 31, wid = F.wave;
    const int t0 = 32 * qt + 4 * wid; const size_t rowbase = (size_t)b * SEQ;
    unsigned W[4] = {0u, 0u, 0u, 0u};
    if (qt < 8) {
#pragma unroll
        for (int lq = 0; lq < 4; ++lq) { const int t = t0 + lq, wb = t >> 5; W[lq] = lane < wb ? 0xffffffffu : (lane == wb ? ((2u << (t & 31)) - 1u) : 0u); }
    } else {
        float sf[2][64];
        const float QNAN = __uint_as_float(0x7fc00000u), NINF = -__builtin_inff(), PINF = __builtin_inff();
        {
            const int hi_i = (j >> 2) & 1, qq_i = (j >> 4) & 1, head_i = ((j >> 3) & 1) * 4 + (j & 3), lq_i = 2 * hi_i + qq_i;
            const bf16* qsrc = WSP(bf16, WS_QI) + (rowbase + t0 + lq_i) * 256 + head_i * 32 + hi * 8;
            const bf16x8 a0 = *(const GAS bf16x8*)qsrc, a1 = *(const GAS bf16x8*)(qsrc + 16);
            float w[2][8];
#pragma unroll
            for (int qq = 0; qq < 2; ++qq) { const float* wp = WSP(float, WS_WI) + (rowbase + t0 + 2 * hi + qq) * 8; const f32x4 x = *(const GAS f32x4*)wp, y = *(const GAS f32x4*)(wp + 4);
                w[qq][0] = x.x; w[qq][1] = x.y; w[qq][2] = x.z; w[qq][3] = x.w; w[qq][4] = y.x; w[qq][5] = y.y; w[qq][6] = y.z; w[qq][7] = y.w; }
            const int sw = j & 3, lim = t0 + 2 * hi - j;
            const LAS unsigned char* kp0 = kl + j * 64 + ((hi ^ sw) << 4);
            const LAS unsigned char* kp1 = kl + j * 64 + (((2 + hi) ^ sw) << 4);
            IDX_LOOP_BEGIN
                const bf16x8 b0 = *(const LAS bf16x8*)(kp0 + kb * 2048), b1 = *(const LAS bf16x8*)(kp1 + kb * 2048);
                att::f32x16 acc = att::f32x16{};
                acc = __builtin_amdgcn_mfma_f32_32x32x16_bf16(a0, b0, acc, 0, 0, 0);
                acc = __builtin_amdgcn_mfma_f32_32x32x16_bf16(a1, b1, acc, 0, 0, 0);
                asm volatile("s_nop 15\n\ts_nop 7" : "+v"(acc));
                float s0 = 0.f, s1 = 0.f;
#pragma unroll
                for (int h = 0; h < 8; ++h) { s0 = fmaf(w[0][h], fmax_s(acc[h], 0.f), s0); s1 = fmaf(w[1][h], fmax_s(acc[8 + h], 0.f), s1); }
                sf[0][kb] = (lim >= 32 * kb) ? s0 : QNAN; sf[1][kb] = (lim + 1 >= 32 * kb) ? s1 : QNAN;
                asm volatile("" : "+v"(sf[0][kb]), "+v"(sf[1][kb])); __builtin_amdgcn_sched_barrier(0);
            IDX_LOOP_END
        }
        int lane2 = F.lane; asm volatile("" : "+v"(lane2)); const int hi2 = lane2 >> 5;
        float mx0 = NINF, mx1 = NINF, mn0 = PINF, mn1 = PINF;
        IDX_LOOP_BEGIN
            mn0 = fmin_s(mn0, sf[0][kb]); mn1 = fmin_s(mn1, sf[1][kb]); mx0 = fmax_s(mx0, sf[0][kb]); mx1 = fmax_s(mx1, sf[1][kb]);
        IDX_LOOP_END
#pragma unroll
        for (int o = 1; o < 32; o <<= 1) { mx0 = fmax_s(mx0, __shfl_xor(mx0, o)); mx1 = fmax_s(mx1, __shfl_xor(mx1, o)); mn0 = fmin_s(mn0, __shfl_xor(mn0, o)); mn1 = fmin_s(mn1, __shfl_xor(mn1, o)); }
        const float d0 = mx0 - mn0, d1 = mx1 - mn1;
        float A0 = d0 > 0.f ? 254.9f * __builtin_amdgcn_rcpf(d0) : 0.f, A1 = d1 > 0.f ? 254.9f * __builtin_amdgcn_rcpf(d1) : 0.f, B0 = 1.0f - mn0 * A0, B1 = 1.0f - mn1 * A1;
#define IDX_BIN(s, A, B) min((unsigned)fmaf((s), (A), (B)), 255u)
        LAS unsigned* hq0 = hist + (2 * hi2) * 128; LAS unsigned* hq1 = hq0 + 128;
        *(LAS v4u*)(hist + lane2 * 8) = (v4u){0u, 0u, 0u, 0u}; *(LAS v4u*)(hist + lane2 * 8 + 4) = (v4u){0u, 0u, 0u, 0u};
        IDX_LOOP_BEGIN
            const float s0 = sf[0][kb], s1 = sf[1][kb]; const unsigned e0 = IDX_BIN(s0, A0, B0), e1 = IDX_BIN(s1, A1, B1);
            IDX_ADD(hq0, e0); IDX_ADD(hq1, e1);
        IDX_LOOP_END
        unsigned binq[4], rem[4], cnteq[4]; float thr[4];
        bool small = true;
#pragma unroll
        for (int lq = 0; lq < 4; ++lq) { unsigned ab; hist_select(hist + lq * 128, lane2, 256u, binq[lq], ab, cnteq[lq]); rem[lq] = 256u - ab; small = small && (cnteq[lq] <= 64u); }
#ifdef DBG_FORCE_FALLBACK
        small = false;
#endif
        if (small) {
            asm volatile("" ::: "memory");
            if (lane2 < 4) hist[lane2 * 128 + 64] = 0u;
            asm volatile("" ::: "memory");
            const unsigned bq0 = hi2 ? binq[2] : binq[0], bq1 = hi2 ? binq[3] : binq[1];
            asm volatile("" : "+v"(A0), "+v"(A1), "+v"(B0), "+v"(B1));
            IDX_LOOP_BEGIN
                const float s0 = sf[0][kb], s1 = sf[1][kb]; const unsigned e0 = IDX_BIN(s0, A0, B0), e1 = IDX_BIN(s1, A1, B1);
                if (e0 == bq0) { const unsigned pos = __hip_atomic_fetch_add(hq0 + 64, 1u, __ATOMIC_RELAXED, __HIP_MEMORY_SCOPE_WORKGROUP); if (pos < 64u) ((LAS float*)hq0)[pos] = s0; }
                if (e1 == bq1) { const unsigned pos = __hip_atomic_fetch_add(hq1 + 64, 1u, __ATOMIC_RELAXED, __HIP_MEMORY_SCOPE_WORKGROUP); if (pos < 64u) ((LAS float*)hq1)[pos] = s1; }
            IDX_LOOP_END
            asm volatile("" ::: "memory");
#pragma unroll
            for (int lq = 0; lq < 4; ++lq) {
                const LAS float* lst = (const LAS float*)(hist + lq * 128); const unsigned c = cnteq[lq];
                const float v = ((unsigned)lane2 < c) ? lst[lane2] : NINF;
                unsigned gt = 0u, ge = 0u;
                for (unsigned q = 0; q < c; ++q) { const float x = lst[q]; gt += (x > v) ? 1u : 0u; ge += (x >= v) ? 1u : 0u; }
                const unsigned rm = rem[lq];
                const unsigned long long bal = __ballot(((unsigned)lane2 < c) && (gt < rm) && (rm <= ge));
                const int L = __builtin_amdgcn_readfirstlane((int)__builtin_ctzll(bal | (1ull << 63)));
                thr[lq] = __uint_as_float((unsigned)__builtin_amdgcn_readlane((int)__float_as_uint(v), L));
                const unsigned g1 = (unsigned)__builtin_amdgcn_readlane((int)gt, L), g2 = (unsigned)__builtin_amdgcn_readlane((int)ge, L);
                rem[lq] = rm - g1; cnteq[lq] = g2 - g1;
            }
        }
#ifndef DBG_NO_FALLBACK
        else {
            unsigned pref[4] = {0u, 0u, 0u, 0u};
#pragma unroll
            for (int lq = 0; lq < 4; ++lq) rem[lq] = 256u;
#pragma nounroll
            for (int pass = 0; pass < 4; ++pass) {
                int shift = 24 - 8 * pass; asm volatile("" : "+s"(shift));
                asm volatile("" ::: "memory");
                *(LAS v4u*)(hist + lane2 * 8) = (v4u){0u, 0u, 0u, 0u}; *(LAS v4u*)(hist + lane2 * 8 + 4) = (v4u){0u, 0u, 0u, 0u};
                const unsigned pv0 = hi2 ? pref[2] : pref[0], pv1 = hi2 ? pref[3] : pref[1];
                IDX_LOOP_BEGIN
                    float s0 = sf[0][kb], s1 = sf[1][kb]; asm volatile("" : "+v"(s0), "+v"(s1));
                    const unsigned k0 = (s0 == s0) ? fkey(s0) : 0u, k1 = (s1 == s1) ? fkey(s1) : 0u;
                    const unsigned dd0 = (k0 >> shift) & 255u, dd1 = (k1 >> shift) & 255u, up0 = (pass == 0) ? 0u : (k0 >> (shift + 8)), up1 = (pass == 0) ? 0u : (k1 >> (shift + 8));
                    if (up0 == pv0) IDX_ADD(hq0, dd0);
                    if (up1 == pv1) IDX_ADD(hq1, dd1);
                IDX_LOOP_END
#pragma unroll
                for (int lq = 0; lq < 4; ++lq) { unsigned dg, ab; hist_select(hist + lq * 128, lane2, rem[lq], dg, ab, cnteq[lq]); pref[lq] = (pref[lq] << 8) | dg; rem[lq] -= ab; }
            }
#pragma unroll
            for (int lq = 0; lq < 4; ++lq) { const unsigned k = pref[lq]; thr[lq] = __uint_as_float((k & 0x80000000u) ? (k & 0x7fffffffu) : ~k); }
        }
#endif
#undef IDX_BIN
        const bool ties = (rem[0] < cnteq[0]) || (rem[1] < cnteq[1]) || (rem[2] < cnteq[2]) || (rem[3] < cnteq[3]);
        const float th0 = hi2 ? thr[2] : thr[0], th1 = hi2 ? thr[3] : thr[1];
#ifdef DBG_NO_TIES
        if (true) {
#else
        if (!ties) {
#endif
            IDX_LOOP_BEGIN
                const unsigned long long b0 = __ballot(sf[0][kb] >= th0), b1 = __ballot(sf[1][kb] >= th1);
                WRLANE(W[0], (unsigned)b0, kb); WRLANE(W[2], (unsigned)(b0 >> 32), kb);
                WRLANE(W[1], (unsigned)b1, kb); WRLANE(W[3], (unsigned)(b1 >> 32), kb);
            IDX_LOOP_END
        } else {
            const unsigned rm0 = hi2 ? rem[2] : rem[0], rm1 = hi2 ? rem[3] : rem[1];
            unsigned run0 = 0u, run1 = 0u;
            IDX_LOOP_BEGIN
#pragma unroll
                for (int qq = 0; qq < 2; ++qq) { const float k = sf[qq][kb], th = qq ? th1 : th0; const unsigned rmq = qq ? rm1 : rm0; unsigned& run = qq ? run1 : run0;
                    const bool eq = (k == th); const unsigned long long be = __ballot(eq);
                    const unsigned rl = __builtin_amdgcn_mbcnt_lo((unsigned)be, 0u), rh = __builtin_amdgcn_mbcnt_hi((unsigned)(be >> 32), 0u);
                    const unsigned rank = run + (hi2 ? rh : rl);
                    const bool sel = (k > th) || (eq && rank < rmq);
                    run += hi2 ? (unsigned)__builtin_popcount((unsigned)(be >> 32)) : (unsigned)__builtin_popcount((unsigned)be);
                    const unsigned long long bs = __ballot(sel);
                    WRLANE(W[qq], (unsigned)bs, kb); WRLANE(W[2 + qq], (unsigned)(bs >> 32), kb); }
            IDX_LOOP_END
        }
    }
    int lane3 = F.lane; asm volatile("" : "+v"(lane3));
    unsigned* mk = WSP(unsigned, WS_MASK) + (rowbase + t0) * 64 + lane3;
#pragma unroll
    for (int lq = 0; lq < 4; ++lq) mk[lq * 64] = W[lq];
}
#undef IDX_LOOP_BEGIN
#undef IDX_LOOP_END
#undef IDX_ADD
__device__ __forceinline__ void idx_phase(Frame& F) {
    const int b = F.vcu >> 3, sub = F.vcu & 7;
    LAS unsigned char* kl = F.lds + RING_OFF; LAS unsigned* hist = (LAS unsigned*)(F.lds + RING_OFF + 131072) + F.wave * 512;
    const bf16* kib = WSP(bf16, WS_KI) + (size_t)b * SEQ * 32;
    for (int i = F.tid; i < SEQ * 4; i += NWAVES * 64) { const int key = i >> 2, c = i & 3; const v4u v = *(const GAS v4u*)(kib + key * 32 + c * 8); *(LAS v4u*)(kl + key * 64 + ((c ^ (key & 3)) << 4)) = v; }
    __syncthreads();
    for (int k = 0; k < 4; ++k) { const int q = sub + 8 * k; idx_task(F, b, q, kl, hist); idx_task(F, b, 63 - q, kl, hist); }
    __syncthreads();
}

struct Args { InPtrs in; float* out; unsigned char* ws; int ph_lo, ph_hi; };
__global__ void __launch_bounds__(NWAVES * 64, 2) hybrid_fwd(Args args) {
    extern __shared__ __attribute__((aligned(16))) unsigned char lds[];
    Frame F;
    F.lds = (LAS unsigned char*)lds;
    F.MISC = (volatile LAS unsigned*)(F.lds + MISC_OFF);
    F.tid = threadIdx.x; F.lane = F.tid & 63; F.wave = __builtin_amdgcn_readfirstlane(F.tid >> 6);
    F.G = gridDim.x; { const int bx = blockIdx.x; F.vcu = (F.G % 8 == 0) ? (bx % 8) * (F.G / 8) + bx / 8 : bx; }
    F.ws = args.ws; F.ctl = (gu32*)(args.ws + WS_CTL);
    const InPtrs& I = args.in;
    for (int u = F.tid; u < (LDS_BYTES - LDSCTL_OFF) / 4; u += NWAVES * 64) ((LAS unsigned*)(F.lds + LDSCTL_OFF))[u] = 0u;
    __syncthreads();
    XcdBarrier bar; bar.bar = (unsigned*)(F.ctl + CW_BAR); bar.x = 0; bar.st = nullptr;
    if (N_LAUNCHES == 1) bar = xcd_barrier_post((unsigned*)(F.ctl + CW_BAR), F.MISC + 8);
#define GRID_BAR() do { if (N_LAUNCHES == 1) xcd_barrier(bar); } while (0)
    const int lo = args.ph_lo, hi = args.ph_hi;
#define IN(k) (lo <= (k) && (k) < hi)
#define BOTH(k) (IN(k) && IN((k) + 1))
    using pg8::bf16_t;

#ifndef PH_MASK
#define PH_MASK 0xFFF
#endif
#define PHON(k) ((PH_MASK >> (k)) & 1)
#ifndef PH_DUP
#define PH_DUP 0x000
#endif
#ifndef DUP_IDX
#define DUP_IDX 0
#endif
#ifndef DUP_MLA
#define DUP_MLA 0
#endif
#define PHDUP(k) ((PH_DUP >> (k)) & 1)
    for (int r_ = 0; r_ < (PHDUP(0) ? 2 : 1); ++r_) if (PHON(0) && IN(0)) { p0_prologue(F, I); if (BOTH(0)) GRID_BAR(); }

    for (int r_ = 0; r_ < (PHDUP(1) ? 2 : 1); ++r_) if (PHON(1) && IN(1)) {
        pg8::Gemm g{WSP(bf16_t, WS_XB), WSP(bf16_t, WS_W_IN), M, N_IN, DM, DM, DM}; pg8::StaticOrder S; S.init(M, N_IN, F.G, (int)blockIdx.x);
        pg8::EpiIn E{WSP(bf16_t, WS_CQ), WSP(bf16_t, WS_CKV), WSP(bf16_t, WS_QB), WSP(bf16_t, WS_KB), WSP(bf16_t, WS_VB), WSP(bf16_t, WS_QI), WSP(bf16_t, WS_SGA), WSP(bf16_t, WS_SGB), WSP(bf16_t, WS_KMLA), WSP(bf16_t, WS_KI),
                     WSP(float, WS_WI), WSP(float, WS_SSQ_Q), WSP(float, WS_SSQ_KV), WSP(float, WS_COS), WSP(float, WS_SIN)};
        pg8::gemm_phase<pg8::EpiIn, pg8::StaticOrder, true>(F.lds + RING_OFF, g, S, E);
        if (BOTH(1)) GRID_BAR();
    }
    for (int r_ = 0; r_ < (PHDUP(2) ? 2 : 1); ++r_) if (PHON(2) && IN(2)) {
#ifndef NO_UQ
        { pg8::Gemm g{WSP(bf16_t, WS_CQ), WSP(bf16_t, WS_W_UQ), M, 768, 256, 256, 256}; pg8::StaticOrder S; S.init(M, 768, F.G, (int)blockIdx.x);
          pg8::EpiUq E{WSP(bf16_t, WS_QMLA), WSP(float, WS_SSQ_Q), WSP(float, WS_COS), WSP(float, WS_SIN)};
          pg8::gemm_phase<pg8::EpiUq, pg8::StaticOrder, true>(F.lds + RING_OFF, g, S, E); }
        __syncthreads();
#endif
#ifndef NO_UKV
        { pg8::Gemm g{WSP(bf16_t, WS_CKV), WSP(bf16_t, WS_W_UKV), M, 1024, 256, 256, 256}; pg8::StaticOrder S; S.init(M, 1024, F.G, (int)blockIdx.x);
          pg8::EpiUkv E{WSP(bf16_t, WS_KMLA), WSP(bf16_t, WS_VA), WSP(float, WS_SSQ_KV)};
          pg8::gemm_phase<pg8::EpiUkv, pg8::StaticOrder, true>(F.lds + RING_OFF, g, S, E); }
#endif
        if (BOTH(2)) GRID_BAR();
    }
    for (int r_ = 0; r_ < (PHDUP(3) ? 2 : 1); ++r_) if (PHON(3) && IN(3)) {
        if (F.G == 256) {
#ifndef NO_IDX
            for (int r2_ = 0; r2_ < (DUP_IDX ? 2 : 1); ++r2_) idx_phase(F);
#endif
#ifndef NO_MLA
            const att::AttnArgs T{WSP(att::bf16, WS_QMLA), 768, WSP(att::bf16, WS_KMLA), 768, WSP(att::bf16, WS_VA), 512, WSP(att::bf16, WS_O), 1024, 0, nullptr};
            const int b = F.vcu >> 3, h = F.vcu & 7;
            for (int r2_ = 0; r2_ < (DUP_MLA ? 2 : 1); ++r2_)
            for (int i = 0; i < 8; ++i) att::attn_unit<6, false>(b, h, 7 - i, T, 0.f, (att::LDSC*)(F.lds + RING_OFF));
#endif
        }
        if (BOTH(3)) GRID_BAR();
    }
    for (int r_ = 0; r_ < (PHDUP(4) ? 2 : 1); ++r_) if (PHON(4) && IN(4)) {
        if (F.G == 256) {
            const att::AttnArgs T{WSP(att::bf16, WS_QB), 512, WSP(att::bf16, WS_KB), 512, WSP(att::bf16, WS_VB), 512, WSP(att::bf16, WS_O), 1024, 512, WSP(unsigned, WS_MASK)};
            const int b = F.vcu >> 3, h = F.vcu & 7; const float slope2 = exp2f(-(float)(h + 1)) * LOG2E;
            for (int i = 0; i < 8; ++i) att::attn_unit<4, true>(b, h, 7 - i, T, slope2, (att::LDSC*)(F.lds + RING_OFF));
        }
        if (BOTH(4)) GRID_BAR();
    }
    for (int r_ = 0; r_ < (PHDUP(5) ? 2 : 1); ++r_) if (PHON(5) && IN(5)) {
        pg8::Gemm g{WSP(bf16_t, WS_O), WSP(bf16_t, WS_W_A), M, 1024, 1024, 1024, 1024}; pg8::StaticOrder S; S.init(M, 1024, F.G, (int)blockIdx.x);
        pg8::EpiGate2 E{WSP(bf16_t, WS_SGA), WSP(bf16_t, WS_SGB), WSP(bf16_t, WS_MIXED)};
        pg8::gemm_phase<pg8::EpiGate2, pg8::StaticOrder, true>(F.lds + RING_OFF, g, S, E);
        if (BOTH(5)) GRID_BAR();
    }
    for (int r_ = 0; r_ < (PHDUP(7) ? 2 : 1); ++r_) if (PHON(7) && IN(7)) {
        pg8::Gemm g{WSP(bf16_t, WS_MIXED), WSP(bf16_t, WS_W_OUT), M, 1024, 1024, 1024, 1024}; pg8::StaticOrder S; S.init(M, 1024, F.G, (int)blockIdx.x);
        pg8::EpiResF32 E{I.x, args.out};
        pg8::gemm_phase<pg8::EpiResF32, pg8::StaticOrder, true>(F.lds + RING_OFF, g, S, E);
        if (BOTH(7)) GRID_BAR();
    }
    for (int r_ = 0; r_ < (PHDUP(8) ? 2 : 1); ++r_) if (PHON(8) && IN(8)) { ln_rows(F, args.out, I.ln1g, I.ln1b, WSP(bf16, WS_H1), nullptr); if (BOTH(8)) GRID_BAR(); }
    for (int r_ = 0; r_ < (PHDUP(9) ? 2 : 1); ++r_) if (PHON(9) && IN(9)) {
        pg8::Gemm g{WSP(bf16_t, WS_H1), WSP(bf16_t, WS_W_FFI), M, 2 * DFF, DM, DM, DM}; pg8::StaticOrder S; S.init(M, 2 * DFF, F.G, (int)blockIdx.x);
        pg8::EpiSwiglu E{WSP(bf16_t, WS_ACT)};
        pg8::gemm_phase<pg8::EpiSwiglu, pg8::StaticOrder, true>(F.lds + RING_OFF, g, S, E);
        if (BOTH(9)) GRID_BAR();
    }
    for (int r_ = 0; r_ < (PHDUP(10) ? 2 : 1); ++r_) if (PHON(10) && IN(10)) {
        pg8::Gemm g{WSP(bf16_t, WS_ACT), WSP(bf16_t, WS_W_DN), M, DM, DFF, DFF, DFF}; pg8::StaticOrder S; S.init(M, DM, F.G, (int)blockIdx.x);
        pg8::EpiResBf E{WSP(bf16_t, WS_H1), args.out};
        pg8::gemm_phase<pg8::EpiResBf, pg8::StaticOrder, true>(F.lds + RING_OFF, g, S, E);
        if (BOTH(10)) GRID_BAR();
    }
    if (PHON(11) && IN(11)) { ln_rows(F, args.out, I.ln2g, I.ln2b, nullptr, args.out); }
#undef IN
#undef BOTH
#undef GRID_BAR
}

extern "C" void kernel_launch(void* const* d_in, const int* in_sizes, int n_in, void* d_out, int out_size, void* d_ws, size_t ws_size, hipStream_t stream) {
    static int grid = 0;
    if (grid == 0) {
        if (n_in != 16 || in_sizes[0] != M * DM || out_size != M * DM || ws_size < WS_END) { fprintf(stderr, "kernel_launch: unexpected sizes (n_in %d, in0 %d, out %d, ws %zu < %zu); nothing launched\n", n_in, n_in > 0 ? in_sizes[0] : -1, out_size, ws_size, (size_t)WS_END); grid = -1; return; }
        int dev = 0, cus = 0, per_cu = 0;
        if (hipGetDevice(&dev) != hipSuccess || hipDeviceGetAttribute(&cus, hipDeviceAttributeMultiprocessorCount, dev) != hipSuccess) { grid = -1; return; }
        if (hipFuncSetAttribute((const void*)hybrid_fwd, hipFuncAttributeMaxDynamicSharedMemorySize, LDS_BYTES) != hipSuccess) { fprintf(stderr, "kernel_launch: hipFuncSetAttribute failed\n"); grid = -1; return; }
        if (hipOccupancyMaxActiveBlocksPerMultiprocessor(&per_cu, (const void*)hybrid_fwd, NWAVES * 64, LDS_BYTES) != hipSuccess || per_cu < 1) { fprintf(stderr, "kernel_launch: occupancy query reports %d workgroups per CU\n", per_cu); }
        (void)hipGetLastError();
        grid = cus;
    }
    if (grid < 0) return;
    if (hipMemsetAsync((char*)d_ws + WS_CTL, 0, CTL_ZERO_BYTES, stream) != hipSuccess) return;
    Args a{};
    a.in.x = (const float*)d_in[0]; a.in.pos = (const int*)d_in[1]; a.in.w_in = (const float*)d_in[2]; a.in.qn = (const float*)d_in[3]; a.in.kvn = (const float*)d_in[4];
    a.in.w_uq = (const float*)d_in[5]; a.in.w_ukv = (const float*)d_in[6]; a.in.w_a = (const float*)d_in[7]; a.in.w_b = (const float*)d_in[8]; a.in.w_out = (const float*)d_in[9];
    a.in.ln1g = (const float*)d_in[10]; a.in.ln1b = (const float*)d_in[11]; a.in.ffi = (const float*)d_in[12]; a.in.ffd = (const float*)d_in[13]; a.in.ln2g = (const float*)d_in[14]; a.in.ln2b = (const float*)d_in[15];
    a.out = (float*)d_out; a.ws = (unsigned char*)d_ws;
    for (int li = 0; li < N_LAUNCHES; ++li) {
        a.ph_lo = (N_LAUNCHES == PER_PHASE) ? li : 0; a.ph_hi = (N_LAUNCHES == PER_PHASE) ? li + 1 : PER_PHASE;
        hipLaunchKernelGGL(hybrid_fwd, dim3(grid), dim3(NWAVES * 64), LDS_BYTES, stream, a);
        if (hipPeekAtLastError() != hipSuccess) { fprintf(stderr, "kernel_launch: launch %d failed\n", li); break; }
    }
}
```
